# Optimizing an MI355X kernel written in HIP

```python
import jax, jax.numpy as jnp
from jax import lax
import numpy as np

D_MODEL = 2048
BATCH = 4
SEQ = 4096
DEPTH = 4

N_MIXERS = 2
HEAD_DIM = 128
N_ATTN_HEADS = 12
ATTN_WIDTH = N_ATTN_HEADS * HEAD_DIM
Q_LORA = 512
KV_LORA = 256
IDX_HEADS = 16
IDX_DIM = 64
TOPK_MAX = 256
Q_BLOCK = 128
POOL_WINDOWS = (2, 4, 8, 16)
N_POOL_GROUPS = len(POOL_WINDOWS)
POOL_WIDTH = 1536
POOL_GROUP = POOL_WIDTH // N_POOL_GROUPS
N_MEM = 256
N_MEM_HEADS = 4
MEM_WIDTH = N_MEM_HEADS * HEAD_DIM
MIX_WIDTH = ATTN_WIDTH + MEM_WIDTH
D_FF = -(-8 * D_MODEL // (3 * 256)) * 256
ATTN_SPLITS = (Q_LORA, KV_LORA, IDX_DIM, IDX_HEADS, MEM_WIDTH)
ATTN_IN = sum(ATTN_SPLITS)
POOL_IN = POOL_WIDTH + MEM_WIDTH
N_ATTN_LAYERS = (DEPTH + 1) // 2
N_POOL_LAYERS = DEPTH // 2
EPS = 1e-6

kernel_name = "dsa_pool_hybrid_trunk"


def rmsnorm(x, g):
    xf = x.astype(jnp.float32)
    y = xf * lax.rsqrt(jnp.mean(xf * xf, axis=-1, keepdims=True) + EPS)
    return (y * g.astype(jnp.float32)).astype(x.dtype)


def layernorm(x, g, b):
    xf = x.astype(jnp.float32)
    mu = jnp.mean(xf, axis=-1, keepdims=True)
    var = jnp.mean(jnp.square(xf - mu), axis=-1, keepdims=True)
    y = (xf - mu) * lax.rsqrt(var + EPS)
    return (y * g.astype(jnp.float32) + b.astype(jnp.float32)).astype(x.dtype)


def split_cols(a, sizes):
    offs = np.cumsum(sizes)[:-1].tolist()
    return jnp.split(a, offs, axis=-1)


def dsa_mixer(h, w_in, q_norm, kv_norm, w_uq, w_uk, w_uv, w_idx_uq, idx_k_norm, idx_k_bias):
    B, T, _ = h.shape
    c_q, c_kv, k_idx, w_idx, q_mem = split_cols(h @ w_in, ATTN_SPLITS)
    c_q = rmsnorm(c_q, q_norm)
    c_kv = rmsnorm(c_kv, kv_norm)
    k_idx = layernorm(k_idx, idx_k_norm, idx_k_bias)
    q = (c_q @ w_uq).reshape(B, T, N_ATTN_HEADS, HEAD_DIM)
    q_abs = jnp.einsum('bthd,hcd->bthc', q, w_uk)
    q_idx = (c_q @ w_idx_uq).reshape(B, T, IDX_HEADS, IDX_DIM)
    w_idx = w_idx * (IDX_HEADS ** -0.5 * IDX_DIM ** -0.5)
    k_top = min(TOPK_MAX, T // 4)
    n_blk = T // Q_BLOCK
    key_pos = jnp.arange(T)
    scale = HEAD_DIM ** -0.5

    def block(i):
        t0 = i * Q_BLOCK
        qi = lax.dynamic_slice_in_dim(q_idx, t0, Q_BLOCK, 1)
        wi = lax.dynamic_slice_in_dim(w_idx, t0, Q_BLOCK, 1)
        qa = lax.dynamic_slice_in_dim(q_abs, t0, Q_BLOCK, 1)
        qpos = t0 + jnp.arange(Q_BLOCK)
        s = jax.nn.relu(jnp.einsum('bqhd,bsd->bqhs', qi, k_idx))
        score = jnp.einsum('bqh,bqhs->bqs', wi, s).astype(jnp.float32)
        causal = key_pos[None, :] <= qpos[:, None]
        score = jnp.where(causal[None], score, -jnp.inf)
        _, sel = lax.top_k(score, k_top)
        valid = sel <= qpos[None, :, None]
        c_sel = jax.vmap(lambda c, ix: c[ix])(c_kv, sel)
        logits = jnp.einsum('bqhc,bqkc->bqhk', qa, c_sel).astype(jnp.float32) * scale
        logits = jnp.where(valid[:, :, None, :], logits, -jnp.inf)
        p = jax.nn.softmax(logits, axis=-1).astype(c_sel.dtype)
        return jnp.einsum('bqhk,bqkc->bqhc', p, c_sel)

    o_lat = lax.map(block, jnp.arange(n_blk))
    o_lat = o_lat.transpose(1, 0, 2, 3, 4).reshape(B, T, N_ATTN_HEADS, KV_LORA)
    o = jnp.einsum('bthc,hcd->bthd', o_lat, w_uv).reshape(B, T, ATTN_WIDTH)
    return o, q_mem


def pool_mixer(h, w_in, w_group, scale):
    B, T, _ = h.shape
    proj = h @ w_in
    u, q_mem = proj[..., :POOL_WIDTH], proj[..., POOL_WIDTH:]
    uf = u.astype(jnp.float32)
    cs = jnp.concatenate([jnp.zeros((B, 1, POOL_WIDTH), jnp.float32), jnp.cumsum(uf, axis=1)], axis=1)
    pos = jnp.arange(T)
    outs = []
    for g, w in enumerate(POOL_WINDOWS):
        sl = slice(g * POOL_GROUP, (g + 1) * POOL_GROUP)
        seg = cs[..., sl]
        start = jnp.maximum(pos + 1 - w, 0)
        total = jnp.take(seg, pos + 1, axis=1) - jnp.take(seg, start, axis=1)
        cnt = (pos + 1 - start).astype(jnp.float32)
        outs.append(total / cnt[None, :, None] - uf[..., sl])
    y = jnp.stack(outs, axis=2).astype(u.dtype)
    y = jnp.einsum('btgc,gcd->btgd', y, w_group).reshape(B, T, POOL_WIDTH) * scale
    return y, q_mem


def mem_attend(q_mem, mem_k, mem_v):
    B, T = q_mem.shape[:2]
    logits = jnp.einsum('bthd,bnhd->bhtn', q_mem, mem_k).astype(jnp.float32) * HEAD_DIM ** -0.5
    p = jax.nn.softmax(logits, axis=-1).astype(mem_v.dtype)
    return jnp.einsum('bhtn,bnhd->bthd', p, mem_v).reshape(B, T, MEM_WIDTH)


def setup_inputs(seed: int = 0) -> dict:
    key = jax.random.key(seed)
    ks = iter(jax.random.split(key, 32))

    def nrm(shape, fan_in):
        return jax.random.normal(next(ks), shape, jnp.float32) * fan_in ** -0.5

    def gain(shape):
        return 1.0 + 0.1 * jax.random.normal(next(ks), shape, jnp.float32)

    return {
        "x": jax.random.normal(next(ks), (BATCH, SEQ, D_MODEL), jnp.float32),
        "mem": jax.random.normal(next(ks), (BATCH, N_MEM, D_MODEL), jnp.float32),
        "mixer_norm": gain((DEPTH, D_MODEL)),
        "ffn_norm": gain((DEPTH, D_MODEL)),
        "final_norm": gain((D_MODEL,)),
        "mem_norm": gain((D_MODEL,)),
        "w_mem_kv": nrm((DEPTH, D_MODEL, 2 * MEM_WIDTH), D_MODEL),
        "w_out": nrm((DEPTH, MIX_WIDTH, D_MODEL), MIX_WIDTH),
        "w_gate": nrm((DEPTH, D_MODEL, D_FF), D_MODEL),
        "w_up": nrm((DEPTH, D_MODEL, D_FF), D_MODEL),
        "w_down": nrm((DEPTH, D_FF, D_MODEL), D_FF),
        "w_in_attn": nrm((N_ATTN_LAYERS, D_MODEL, ATTN_IN), D_MODEL),
        "q_norm": gain((N_ATTN_LAYERS, Q_LORA)),
        "kv_norm": gain((N_ATTN_LAYERS, KV_LORA)),
        "w_uq": nrm((N_ATTN_LAYERS, Q_LORA, ATTN_WIDTH), Q_LORA),
        "w_uk": nrm((N_ATTN_LAYERS, N_ATTN_HEADS, KV_LORA, HEAD_DIM), HEAD_DIM),
        "w_uv": nrm((N_ATTN_LAYERS, N_ATTN_HEADS, KV_LORA, HEAD_DIM), KV_LORA),
        "w_idx_uq": nrm((N_ATTN_LAYERS, Q_LORA, IDX_HEADS * IDX_DIM), Q_LORA),
        "idx_k_norm": gain((N_ATTN_LAYERS, IDX_DIM)),
        "idx_k_bias": 0.02 * jax.random.normal(next(ks), (N_ATTN_LAYERS, IDX_DIM), jnp.float32),
        "w_in_pool": nrm((N_POOL_LAYERS, D_MODEL, POOL_IN), D_MODEL),
        "w_pool_group": nrm((N_POOL_LAYERS, N_POOL_GROUPS, POOL_GROUP, POOL_GROUP), POOL_GROUP),
        "pool_scale": gain((N_POOL_LAYERS, POOL_WIDTH)),
    }


def reference(x, mem, mixer_norm, ffn_norm, final_norm, mem_norm, w_mem_kv, w_out, w_gate, w_up, w_down,
              w_in_attn, q_norm, kv_norm, w_uq, w_uk, w_uv, w_idx_uq, idx_k_norm, idx_k_bias,
              w_in_pool, w_pool_group, pool_scale):
    B, T, _ = x.shape
    mem_n = rmsnorm(mem, mem_norm)
    for i in range(DEPTH):
        h = rmsnorm(x, mixer_norm[i])
        j = i // N_MIXERS
        if i % N_MIXERS == 0:
            y, q_mem = dsa_mixer(h, w_in_attn[j], q_norm[j], kv_norm[j], w_uq[j], w_uk[j], w_uv[j],
                                 w_idx_uq[j], idx_k_norm[j], idx_k_bias[j])
        else:
            y, q_mem = pool_mixer(h, w_in_pool[j], w_pool_group[j], pool_scale[j])
        kv = mem_n @ w_mem_kv[i]
        mk = kv[..., :MEM_WIDTH].reshape(B, N_MEM, N_MEM_HEADS, HEAD_DIM)
        mv = kv[..., MEM_WIDTH:].reshape(B, N_MEM, N_MEM_HEADS, HEAD_DIM)
        m = mem_attend(q_mem.reshape(B, T, N_MEM_HEADS, HEAD_DIM), mk, mv)
        x = x + jnp.concatenate([y, m], axis=-1) @ w_out[i]
        h = rmsnorm(x, ffn_norm[i])
        x = x + (jax.nn.silu(h @ w_gate[i]) * (h @ w_up[i])) @ w_down[i]
    return rmsnorm(x, final_norm)
```

```cpp
#include <hip/hip_runtime.h>
#include <cstdio>
#include <cstdint>

#ifndef MK_N_LAUNCHES
#define MK_N_LAUNCHES 1
#endif

#ifndef PROBE_MASK
#define PROBE_MASK 0u
#endif
#define NREP(k) (1 + (int)((PROBE_MASK >> (k)) & 1u))
#ifndef DSA_PROBE
#define DSA_PROBE 0
#endif
#define LAS __attribute__((address_space(3)))
#define GAS __attribute__((address_space(1)))
typedef unsigned short bf16_t;
typedef short bf16x8 __attribute__((ext_vector_type(8)));
typedef short s16x4 __attribute__((ext_vector_type(4)));
typedef float f32x4 __attribute__((ext_vector_type(4)));
typedef float f32x2 __attribute__((ext_vector_type(2)));
typedef float f32x16 __attribute__((ext_vector_type(16)));
typedef unsigned u32x4 __attribute__((ext_vector_type(4)));
typedef unsigned u32x2 __attribute__((ext_vector_type(2)));
typedef __bf16 hbf16x2 __attribute__((ext_vector_type(2)));
typedef int i32x4 __attribute__((ext_vector_type(4)));
typedef int i32x8 __attribute__((ext_vector_type(8)));

constexpr int D = 2048, NB = 4, T = 4096, M = NB * T, DEPTH = 4;
constexpr int HD = 128, NH = 12, QL = 512, KVL = 256, IH = 16, IDM = 64, TOPK = 256;
constexpr int QABS_W_ = 12 * 256;
constexpr int NMEM = 256, MH = 4, MW = 512, DFF = 5632, ATTN_IN = 1360, PW = 1536, PGW = 384;
constexpr int YW8 = QABS_W_ + MW  , ATTN_IN_PAD = 1536, NQ = 4096  , QABS_W = NH * KVL  ;
constexpr float EPS = 1e-6f;

constexpr size_t al256(size_t x) { return (x + 255) & ~(size_t)255; }
constexpr size_t WS_CTL = 0, CTL_BYTES = 1u << 20;
constexpr size_t SZ_BT_GU = (size_t)2 * DFF * D  , SZ_BT_DOWN = (size_t)D * DFF  , SZ_BT_OUT = (size_t)D * D * 2;
constexpr size_t SZ_BT_INATTN = (size_t)ATTN_IN_PAD * D * 2, SZ_BT_Q = (size_t)NQ * QL * 2, SZ_BT_UV = (size_t)1536 * 512 * 2;
constexpr size_t SZ_BT_INPOOL = (size_t)D * D * 2, SZ_BT_GROUP = (size_t)2048 * PGW * 2, SZ_BT_MEMKV = (size_t)4096 * D * 2, SZ_BT_OUTT = (size_t)D * PW * 2;
constexpr size_t WS_BT_GU = WS_CTL + CTL_BYTES;
constexpr size_t WS_BT_DOWN = WS_BT_GU + 4 * SZ_BT_GU;
constexpr size_t WS_BT_OUT = WS_BT_DOWN + 4 * SZ_BT_DOWN;
constexpr size_t WS_BT_INATTN = WS_BT_OUT + 4 * SZ_BT_OUT;
constexpr size_t WS_BT_Q = WS_BT_INATTN + 2 * SZ_BT_INATTN;
constexpr size_t WS_BT_UV = WS_BT_Q + 2 * SZ_BT_Q;
constexpr size_t WS_BT_INPOOL = WS_BT_UV + 2 * SZ_BT_UV;
constexpr size_t WS_BT_GROUP = WS_BT_INPOOL + 2 * SZ_BT_INPOOL;
constexpr size_t WS_BT_OUTT = WS_BT_GROUP + 2 * SZ_BT_GROUP;
constexpr size_t WS_BT_OUTTD = WS_BT_OUTT + 2 * SZ_BT_OUTT;
constexpr size_t WS_BT_MEMKV = WS_BT_OUTTD + 2 * SZ_BT_OUTT;
constexpr size_t WS_MEMN = WS_BT_MEMKV + SZ_BT_MEMKV;
constexpr size_t WS_MKV = WS_MEMN + (size_t)1024 * D * 2;
constexpr size_t WS_XRES = WS_MKV + (size_t)1024 * 4096 * 2;
constexpr size_t WS_H = WS_XRES + (size_t)M * D * 4;
constexpr size_t WS_R0 = WS_H + (size_t)M * D * 2;
constexpr size_t R0_B = (size_t)M * 1536 * 4, R0_C = R0_B + (size_t)M * 1536 * 2;
constexpr size_t SZ_R0 = R0_C + (size_t)M * D * 2;
static_assert((size_t)M * DFF * 2 <= SZ_R0 && (size_t)M * QABS_W * 2 <= R0_B && (size_t)M * 1024 * 2 <= R0_C - R0_B, "arena");
constexpr size_t WS_CQN = WS_R0 + SZ_R0;
constexpr size_t WS_CKV = WS_CQN + (size_t)M * QL * 2;
constexpr size_t WS_KIDX = WS_CKV + (size_t)M * KVL * 2;
constexpr size_t WS_WIDX = WS_KIDX + (size_t)M * IDM * 2;
constexpr size_t WS_RSTD = WS_WIDX + (size_t)M * IH * 4;
constexpr size_t WS_PART = WS_RSTD + (size_t)M * 4;
constexpr size_t WS_QMEM = WS_PART + (size_t)M * 32 * 4;
constexpr size_t WS_OLAT = WS_QMEM + (size_t)M * MW * 2;
constexpr size_t WS_END = WS_OLAT + (size_t)M * QABS_W * 2;

constexpr int RING_BYTES = 131072;
constexpr int LDS_IDX_OFF = RING_BYTES, IDX_STRIDE = 384;
constexpr int LDS_MISC_OFF = RING_BYTES + 6144;
constexpr int LDS_BYTES = 147456;
constexpr int NWAVES = 8;

__device__ __forceinline__ unsigned cvtpk(float lo, float hi) { f32x2 v = {lo, hi}; hbf16x2 b = __builtin_convertvector(v, hbf16x2); return __builtin_bit_cast(unsigned, b); }
__device__ __forceinline__ unsigned cvt4_fp8(float a, float b, float c, float d) { int w = 0; w = __builtin_amdgcn_cvt_pk_fp8_f32(a, b, w, false); w = __builtin_amdgcn_cvt_pk_fp8_f32(c, d, w, true); return (unsigned)w; }
constexpr float QA8_SCALE = 16.0f;
constexpr float Y8_SCALE = 16.0f;
constexpr float GU8_SCALE = 8.0f;
constexpr float W8_SCALE = 64.0f;
__device__ __forceinline__ float bf2f(unsigned short h) { return __builtin_bit_cast(float, (unsigned)h << 16); }
__device__ __forceinline__ float wave_sum(float v) {
#pragma unroll
    for (int o = 1; o < 64; o <<= 1) v += __shfl_xor(v, o);
    return v;
}
__device__ __forceinline__ int wave_isum(int v) {
#pragma unroll
    for (int o = 1; o < 64; o <<= 1) v += __shfl_xor(v, o);
    return __builtin_amdgcn_readfirstlane(v);
}
#define VM_WAIT() asm volatile("s_waitcnt vmcnt(0)" ::: "memory")
#define LGKM_WAIT() asm volatile("s_waitcnt lgkmcnt(0)" ::: "memory")

#define XB_TMO      128
#define XB_XCNT(j)  (256  + 64 * (j))
#define XB_XSUB(j)  (1280 + 64 * (j))
#define XB_XGEN(j)  (2304 + 64 * (j))
#define XB_TOP      3328
#define XB_TOPGEN   3392
#define XCD_BAR_WORDS 3456
#define XB_SPIN_CAP (1u << 22)

__device__ __forceinline__ unsigned xb_ld(unsigned* p)              { return __hip_atomic_load(p, __ATOMIC_RELAXED, __HIP_MEMORY_SCOPE_AGENT); }
__device__ __forceinline__ unsigned xb_add(unsigned* p, unsigned v) { return __hip_atomic_fetch_add(p, v, __ATOMIC_RELAXED, __HIP_MEMORY_SCOPE_AGENT); }
__device__ __forceinline__ unsigned xb_xcc_id() { return (unsigned)__builtin_amdgcn_s_getreg((3 << 11) | 20) & 0xFu; }
#define XB_SPIN(cond, bar) do { unsigned _sp = 0; while (cond) { __builtin_amdgcn_s_sleep(1); \
    if ((++_sp & 255u) == 0u) { if (xb_ld(&(bar)[XB_TMO])) break; if (_sp > XB_SPIN_CAP) { atomicAdd(&(bar)[XB_TMO], 1u); break; } } } } while (0)

__device__ __forceinline__ int lane_now() { int ln; asm volatile("v_mbcnt_lo_u32_b32 %0, -1, 0\n\tv_mbcnt_hi_u32_b32 %0, -1, %0" : "=v"(ln)); return ln; }
struct XcdBarrier { unsigned* bar; unsigned x; volatile LAS unsigned* st; int wv; };

__device__ __forceinline__ XcdBarrier xcd_barrier_post(unsigned* bar, volatile LAS unsigned* st, int wv) {
    XcdBarrier b; b.bar = bar; b.x = xb_xcc_id(); b.st = st; b.wv = wv;
    if (wv == 0 && lane_now() == 0) (void)xb_add(&bar[XB_XCNT(b.x)], 1u);
    return b;
}
__device__ __forceinline__ void xcd_barrier_complete(unsigned* bar, unsigned x, unsigned& nloc, unsigned& nx) {
    const unsigned G = gridDim.x * gridDim.y * gridDim.z;
    unsigned sum, cnt, mine, sp = 0u;
    for (;;) {
        sum = 0u; cnt = 0u; mine = 0u;
#pragma unroll
        for (unsigned j = 0; j < 16; ++j) { const unsigned c = xb_ld(&bar[XB_XCNT(j)]); sum += c; cnt += (c > 0u) ? 1u : 0u; mine = (j == x) ? c : mine; }
        if (sum == G) break;
        __builtin_amdgcn_s_sleep(1);
        if ((++sp & 255u) == 0u) { if (xb_ld(&bar[XB_TMO])) break; if (sp > XB_SPIN_CAP) { atomicAdd(&bar[XB_TMO], 1u); break; } }
    }
    nloc = mine > 0u ? mine : 1u; nx = cnt > 0u ? cnt : 1u;
}
__device__ __forceinline__ void xcd_barrier(const XcdBarrier& b) {
    asm volatile("s_waitcnt vmcnt(0)" ::: "memory");
    __syncthreads();
    if (b.wv == 0 && lane_now() == 0) {
        unsigned* bar = b.bar;
        __builtin_amdgcn_s_waitcnt(0);
        unsigned nloc = b.st[0], nx = b.st[1];
        if (nloc == 0u) { xcd_barrier_complete(bar, b.x, nloc, nx); b.st[0] = nloc; b.st[1] = nx; }
        const unsigned old = xb_add(&bar[XB_XSUB(b.x)], 1u);
        const unsigned gen = old / nloc;
        if (old + 1u == (gen + 1u) * nloc) {
            __builtin_amdgcn_fence(__ATOMIC_RELEASE, "agent");
            asm volatile("s_waitcnt vmcnt(0)" ::: "memory");
            const unsigned og = xb_add(&bar[XB_TOP], 1u);
            const unsigned tg = og / nx;
            if (og + 1u == (tg + 1u) * nx) xb_add(&bar[XB_TOPGEN], 1u);
            else XB_SPIN(xb_ld(&bar[XB_TOPGEN]) == tg, bar);
            __builtin_amdgcn_fence(__ATOMIC_ACQUIRE, "agent");
            xb_add(&bar[XB_XGEN(b.x)], 1u);
            asm volatile("s_waitcnt vmcnt(0)" ::: "memory");
        } else {
            XB_SPIN(xb_ld(&bar[XB_XGEN(b.x)]) == gen, bar);
            __builtin_amdgcn_fence(__ATOMIC_ACQUIRE, "agent");
            asm volatile("s_waitcnt vmcnt(0)" ::: "memory");
        }
    }
    __syncthreads();
}

namespace pg8 {
constexpr int BM = 256, BK = 64, HALF = 128, HTB = HALF * BK * 2, STAGE_BYTES = 8 * HTB, NXCD = 8, WGM = 8;
__host__ __device__ __forceinline__ int lds_byte(int r, int c) { const int st = (r >> 4) * 2 + (c >> 5), rr = r & 15, cc = c & 31, ob = rr * 64 + cc * 2; return st * 1024 + (ob ^ (((ob >> 9) & 1) << 5)); }
__host__ __device__ __forceinline__ void stage_rc(int b, int& R, int& C) { const int st = b / 1024, sb = b % 1024, swz = sb ^ (((sb >> 9) & 1) << 5); R = (st >> 1) * 16 + swz / 64; C = (st & 1) * 32 + (swz % 64) / 2; }
__host__ __device__ __forceinline__ int perm32(int rho) { const int n = rho >> 4, i = rho & 15; return 8 * (i >> 2) + 4 * n + (i & 3); }

struct Unit { int pm, pn; };
struct Gemm { const bf16_t* A; const bf16_t* Bt; int lda, ldb, K, nM, nN, a_div, a_koff; };

struct StaticOrder {
    int nM, nN, nwg, G, c;
    __device__ void init(int nM_, int nN_, int G_, int c_) { nM = nM_; nN = nN_; nwg = nM * nN; G = G_; c = c_; }
    __device__ bool next(int i, Unit& u) const {
        const long L = (long)i * G + c; if (L >= nwg) return false;
        int wgid = (int)L; { const int q = nwg / NXCD, r = nwg % NXCD, xcd = wgid % NXCD, off = wgid / NXCD; wgid = (xcd < r ? xcd * (q + 1) : r * (q + 1) + (xcd - r) * q) + off; }
        const int nig = WGM * nN, gid = wgid / nig, fm = gid * WGM, gsz = (nM - fm) < WGM ? (nM - fm) : WGM;
        u.pm = fm + ((wgid % nig) % gsz); u.pn = (wgid % nig) / gsz; return true;
    }
};

struct EpiF32 {
    static constexpr bool PERM = false;
    float* C; int ldc; const float* rs;
    __device__ __forceinline__ void operator()(const f32x4 (&acc)[2][2][4][2], const Unit& u, int wr, int wc, int fr, int fq) const {
        const int row0 = u.pm * BM + wr * 64 + fr, col0 = u.pn * BM + wc * 32 + 4 * fq;
#pragma unroll
        for (int ai = 0; ai < 2; ++ai)
#pragma unroll
            for (int m = 0; m < 4; ++m) { float* rowp = C + (size_t)(row0 + ai * HALF + m * 16) * ldc + col0; const float r = rs[row0 + ai * HALF + m * 16];
#pragma unroll
                for (int bj = 0; bj < 2; ++bj)
#pragma unroll
                    for (int n = 0; n < 2; ++n) *(f32x4*)(rowp + bj * HALF + n * 16) = acc[ai][bj][m][n] * r; }
    }
};
struct EpiSplit {
    static constexpr bool PERM = true;
    bf16_t* O0; int ld0; bf16_t* O1; int ld1; int split; float osc;
    __device__ __forceinline__ void operator()(const f32x4 (&acc)[2][2][4][2], const Unit& u, int wr, int wc, int fr, int fq) const {
        const int row0 = u.pm * BM + wr * 64 + fr;
        bf16_t* base; int ld, colt;
        if (u.pn < split) { base = O0; ld = ld0; colt = u.pn * BM; } else { base = O1; ld = ld1; colt = (u.pn - split) * BM; }
        const int col0 = colt + wc * 32 + 8 * fq;
#pragma unroll
        for (int ai = 0; ai < 2; ++ai)
#pragma unroll
            for (int m = 0; m < 4; ++m) { bf16_t* rowp = base + (size_t)(row0 + ai * HALF + m * 16) * ld + col0;
#pragma unroll
                for (int bj = 0; bj < 2; ++bj) { const f32x4 v0 = acc[ai][bj][m][0] * osc, v1 = acc[ai][bj][m][1] * osc;
                    u32x4 w; w.x = cvtpk(v0[0], v0[1]); w.y = cvtpk(v0[2], v0[3]); w.z = cvtpk(v1[0], v1[1]); w.w = cvtpk(v1[2], v1[3]);
                    *(u32x4*)(rowp + bj * HALF) = w; } }
    }
};
template <bool W8>
struct EpiResid {
    static constexpr bool PERM = true;
    bf16_t* X; unsigned char* X8; float* part; float osc;
    __device__ __forceinline__ void operator()(const f32x4 (&acc)[2][2][4][2], const Unit& u, int wr, int wc, int, int) const {
        const int ln = lane_now(), fr = ln & 15, fq = ln >> 4;
        const int row0 = u.pm * BM + wr * 64 + fr, col0 = u.pn * BM + wc * 32 + 8 * fq;
#pragma unroll
        for (int ai = 0; ai < 2; ++ai) {
            u32x4 xv[4][2];
#pragma unroll
            for (int m = 0; m < 4; ++m)
#pragma unroll
                for (int bj = 0; bj < 2; ++bj) xv[m][bj] = *(const u32x4*)(X + (size_t)(row0 + ai * HALF + m * 16) * D + col0 + bj * HALF);
#pragma unroll
            for (int m = 0; m < 4; ++m) { const int row = row0 + ai * HALF + m * 16; float ss = 0.f;
#pragma unroll
                for (int bj = 0; bj < 2; ++bj) { const unsigned xw[4] = {xv[m][bj].x, xv[m][bj].y, xv[m][bj].z, xv[m][bj].w}; float v[8];
#pragma unroll
                    for (int e = 0; e < 4; ++e) { v[2 * e] = __builtin_bit_cast(float, xw[e] << 16) + acc[ai][bj][m][e >> 1][2 * (e & 1)] * osc; v[2 * e + 1] = __builtin_bit_cast(float, xw[e] & 0xffff0000u) + acc[ai][bj][m][e >> 1][2 * (e & 1) + 1] * osc; }
#pragma unroll
                    for (int e = 0; e < 8; ++e) ss += v[e] * v[e];
                    u32x4 w; w.x = cvtpk(v[0], v[1]); w.y = cvtpk(v[2], v[3]); w.z = cvtpk(v[4], v[5]); w.w = cvtpk(v[6], v[7]);
                    *(u32x4*)(X + (size_t)row * D + col0 + bj * HALF) = w;
                    if constexpr (W8) { u32x2 w8; w8.x = cvt4_fp8(v[0], v[1], v[2], v[3]); w8.y = cvt4_fp8(v[4], v[5], v[6], v[7]); *(u32x2*)(X8 + (size_t)row * D + col0 + bj * HALF) = w8; } }
                ss += __shfl_xor(ss, 16); ss += __shfl_xor(ss, 32);
                if (fq == 0) part[(size_t)row * 32 + 4 * u.pn + wc] = ss; }
        }
    }
};
struct EpiSplitRS {
    static constexpr bool PERM = true;
    bf16_t* O0; int ld0; bf16_t* O1; int ld1; int split; const float* rs;
    __device__ __forceinline__ void operator()(const f32x4 (&acc)[2][2][4][2], const Unit& u, int wr, int wc, int, int) const {
        const int ln = lane_now(), fr = ln & 15, fq = ln >> 4;
        const int row0 = u.pm * BM + wr * 64 + fr;
        bf16_t* base; int ld, colt;
        if (u.pn < split) { base = O0; ld = ld0; colt = u.pn * BM; } else { base = O1; ld = ld1; colt = (u.pn - split) * BM; }
        const int col0 = colt + wc * 32 + 8 * fq;
#pragma unroll
        for (int ai = 0; ai < 2; ++ai)
#pragma unroll
            for (int m = 0; m < 4; ++m) { const int row = row0 + ai * HALF + m * 16; bf16_t* rowp = base + (size_t)row * ld + col0; const float r = rs[row];
#pragma unroll
                for (int bj = 0; bj < 2; ++bj) { const f32x4 v0 = acc[ai][bj][m][0] * r, v1 = acc[ai][bj][m][1] * r;
                    u32x4 w; w.x = cvtpk(v0[0], v0[1]); w.y = cvtpk(v0[2], v0[3]); w.z = cvtpk(v1[0], v1[1]); w.w = cvtpk(v1[2], v1[3]);
                    *(u32x4*)(rowp + bj * HALF) = w; } }
    }
};
struct EpiFp8 {
    static constexpr bool PERM = true;
    unsigned char* O; int ldc; float osc; int split, loff;
    __device__ __forceinline__ void operator()(const f32x4 (&acc)[2][2][4][2], const Unit& u, int wr, int wc, int fr, int fq) const {
        const int ln = lane_now();
        const int row0 = u.pm * BM + wr * 64 + (ln & 15), col0 = u.pn * BM + wc * 32 + 8 * (ln >> 4) + (u.pn >= split ? loff : 0);
#pragma unroll
        for (int ai = 0; ai < 2; ++ai)
#pragma unroll
            for (int m = 0; m < 4; ++m) { unsigned char* rowp = O + (size_t)(row0 + ai * HALF + m * 16) * ldc + col0;
#pragma unroll
                for (int bj = 0; bj < 2; ++bj) { const f32x4 v0 = acc[ai][bj][m][0] * osc, v1 = acc[ai][bj][m][1] * osc;
                    u32x2 w; w.x = cvt4_fp8(v0[0], v0[1], v0[2], v0[3]); w.y = cvt4_fp8(v1[0], v1[1], v1[2], v1[3]);
                    *(u32x2*)(rowp + bj * HALF) = w; } }
    }
};
struct EpiSwiGLU {
    static constexpr bool PERM = true;
    unsigned char* O; int ldc; float osc; const float* rs;
    __device__ __forceinline__ void operator()(const f32x4 (&acc)[2][2][4][2], const Unit& u, int wr, int wc, int, int) const {
        const int ln = lane_now(), fr = ln & 15, fq = ln >> 4;
        const int row0 = u.pm * BM + wr * 64 + fr, col0 = u.pn * HALF + wc * 32 + 8 * fq;
#pragma unroll
        for (int ai = 0; ai < 2; ++ai)
#pragma unroll
            for (int m = 0; m < 4; ++m) { unsigned char* rowp = O + (size_t)(row0 + ai * HALF + m * 16) * ldc + col0; const float sg = osc * rs[row0 + ai * HALF + m * 16];
                const f32x2 c1 = (f32x2){-1.4426950408889634f * sg, -1.4426950408889634f * sg}, c2 = (f32x2){sg * sg * GU8_SCALE, sg * sg * GU8_SCALE};
                float o[8];
#pragma unroll
                for (int n = 0; n < 2; ++n)
#pragma unroll
                    for (int jp = 0; jp < 2; ++jp) { const f32x2 G = (f32x2){acc[ai][0][m][n][2 * jp], acc[ai][0][m][n][2 * jp + 1]}, U = (f32x2){acc[ai][1][m][n][2 * jp], acc[ai][1][m][n][2 * jp + 1]};
                        const f32x2 t = G * U, a = G * c1; const f32x2 d = (f32x2){__builtin_amdgcn_exp2f(a.x), __builtin_amdgcn_exp2f(a.y)} + (f32x2){1.0f, 1.0f};
                        const f32x2 r = (f32x2){__builtin_amdgcn_rcpf(d.x), __builtin_amdgcn_rcpf(d.y)}; const f32x2 q = (t * c2) * r; o[n * 4 + 2 * jp] = q.x; o[n * 4 + 2 * jp + 1] = q.y; }
                u32x2 w; w.x = cvt4_fp8(o[0], o[1], o[2], o[3]); w.y = cvt4_fp8(o[4], o[5], o[6], o[7]);
                *(u32x2*)rowp = w; }
    }
};
struct EpiGroup {
    static constexpr bool PERM = true;
    bf16_t* O; int ldc; int goff;
    __device__ __forceinline__ void operator()(const f32x4 (&acc)[2][2][4][2], const Unit& u, int wr, int wc, int fr, int fq) const {
        int ln; asm volatile("v_mbcnt_lo_u32_b32 %0, -1, 0\n\tv_mbcnt_hi_u32_b32 %0, -1, %0" : "=v"(ln));
        const int row0 = u.pm * BM + wr * 64 + (ln & 15), g = u.pn >> 1, half = u.pn & 1, c0 = 256 * half + wc * 32 + 8 * (ln >> 4);
        bf16_t* base = O + (size_t)row0 * ldc + PGW * g + c0 + (g >= 4 ? goff : 0);
#pragma unroll
        for (int ai = 0; ai < 2; ++ai)
#pragma unroll
            for (int m = 0; m < 4; ++m) { bf16_t* rowp = base + (size_t)(ai * HALF + m * 16) * ldc;
#pragma unroll
                for (int bj = 0; bj < 2; ++bj) { const f32x4 a0 = acc[ai][bj][m][0], a1 = acc[ai][bj][m][1];
                    u32x4 w; w.x = cvtpk(a0[0], a0[1]); w.y = cvtpk(a0[2], a0[3]); w.z = cvtpk(a1[0], a1[1]); w.w = cvtpk(a1[2], a1[3]);
                    if (bj == 0 || half == 0) *(u32x4*)(rowp + bj * HALF) = w; } }
    }
};

template <class Epi, bool FP8 = false>
__device__ __forceinline__ void gemm_phase(LAS unsigned char* lds, int tid, int wid, const Gemm g, const StaticOrder& S, const Epi& E) {
    const int lane = tid & 63, wr = wid >> 2, wc = wid & 3, fr = lane & 15, fq = lane >> 4;
    const int K = g.K, nt = K / BK;
    unsigned voffA[2], voffB[2];
#pragma unroll
    for (int i = 0; i < 2; ++i) { int R, C; stage_rc(tid * 16 + i * 8192, R, C); const int Rb = Epi::PERM ? ((R & ~31) + perm32(R & 31)) : R;
        voffA[i] = (unsigned)(R * g.lda + C) * 2u; voffB[i] = (unsigned)(Rb * g.ldb + C) * 2u; }
    const size_t kstep = (size_t)(BK * 2);
    const size_t hA = (size_t)HALF * g.lda * 2, hB = (size_t)HALF * g.ldb * 2;
    const unsigned ldsw = (unsigned)wid * 1024u;
    const int aoff = lds_byte(wr * 64 + fr, fq * 8), boff = lds_byte(wc * 32 + fr, fq * 8);
    LAS unsigned char* const ldsA = lds + aoff; LAS unsigned char* const ldsB = lds + 4 * HTB + boff;
#define PG8_SA(b, h) (((b) * 2 + (h)) * HTB)
#define PG8_SB(b, h) ((4 + (b) * 2 + (h)) * HTB)
#define PG8_STAGE(bufoff, gbase, voff) do { _Pragma("unroll") for (int _i = 0; _i < 2; ++_i) \
        __builtin_amdgcn_global_load_lds((const unsigned*)((const char*)(gbase) + (voff)[_i]), (LAS unsigned*)(lds + (bufoff) + ldsw + _i * 8192), 16, 0, 0); } while (0)
#define PG8_LDA(dst, b, h) do { if constexpr (FP8) { _Pragma("unroll") for (int m = 0; m < 4; ++m) { const i32x4 lo_ = *(const LAS i32x4*)(ldsA + PG8_SA(b, h) + m * 2048), hi_ = *(const LAS i32x4*)(ldsA + PG8_SA(b, h) + m * 2048 + 1024); \
            dst##8[m] = __builtin_shufflevector(lo_, hi_, 0, 1, 2, 3, 4, 5, 6, 7); } } \
        else { _Pragma("unroll") for (int m = 0; m < 4; ++m) _Pragma("unroll") for (int k = 0; k < 2; ++k) dst[m][k] = *(const LAS bf16x8*)(ldsA + PG8_SA(b, h) + m * 2048 + k * 1024); } } while (0)
#define PG8_LDB(dst, b, h) do { if constexpr (FP8) { _Pragma("unroll") for (int n = 0; n < 2; ++n) { const i32x4 lo_ = *(const LAS i32x4*)(ldsB + PG8_SA(b, h) + n * 2048), hi_ = *(const LAS i32x4*)(ldsB + PG8_SA(b, h) + n * 2048 + 1024); \
            dst##8[n] = __builtin_shufflevector(lo_, hi_, 0, 1, 2, 3, 4, 5, 6, 7); } } \
        else { _Pragma("unroll") for (int n = 0; n < 2; ++n) _Pragma("unroll") for (int k = 0; k < 2; ++k) dst[n][k] = *(const LAS bf16x8*)(ldsB + PG8_SA(b, h) + n * 2048 + k * 1024); } } while (0)
#define PG8_MMA(ai, bj, At, Bt) do { __builtin_amdgcn_s_setprio(1); \
        if constexpr (FP8) { _Pragma("unroll") for (int m = 0; m < 4; ++m) _Pragma("unroll") for (int n = 0; n < 2; ++n) \
            asm("v_mfma_f32_16x16x128_f8f6f4 %0, %1, %2, %0" : "+v"(acc[ai][bj][m][n]) : "v"(Bt##8[n]), "v"(At##8[m])); } \
        else { _Pragma("unroll") for (int m = 0; m < 4; ++m) _Pragma("unroll") for (int n = 0; n < 2; ++n) _Pragma("unroll") for (int k = 0; k < 2; ++k) \
            acc[ai][bj][m][n] = __builtin_amdgcn_mfma_f32_16x16x32_bf16(Bt[n][k], At[m][k], acc[ai][bj][m][n], 0, 0, 0); } \
        __builtin_amdgcn_s_setprio(0); } while (0)
#define PG8_WAIT_V(n) asm volatile("s_waitcnt vmcnt(" #n ")" ::: "memory")
#define PG8_WAIT_L(n) do { __builtin_amdgcn_s_waitcnt(0xC07F | ((n) << 8)); asm volatile("" ::: "memory"); } while (0)
#define PG8_BAR __builtin_amdgcn_s_barrier()
#define PG8_SCHED __builtin_amdgcn_sched_barrier(0)
    Unit cur, nxt; int ui = 0;
    if (!S.next(0, cur)) return;
    f32x4 acc[2][2][4][2];
#pragma unroll
    for (int a = 0; a < 2; ++a)
#pragma unroll
        for (int b = 0; b < 2; ++b)
#pragma unroll
            for (int m = 0; m < 4; ++m)
#pragma unroll
                for (int n = 0; n < 2; ++n) acc[a][b][m][n] = (f32x4){0.f, 0.f, 0.f, 0.f};
    bf16x8 At[4][2], B0[2][2], B1[2][2];
    i32x8 At8[4], B08[2], B18[2];
    const char* cA = (const char*)g.A + ((size_t)cur.pm * BM * g.lda + (size_t)(cur.pn / g.a_div) * g.a_koff) * 2; const char* cB = (const char*)g.Bt + (size_t)cur.pn * BM * g.ldb * 2;
    PG8_STAGE(PG8_SB(0, 0), cB, voffB); PG8_STAGE(PG8_SB(0, 1), cB + hB, voffB); PG8_STAGE(PG8_SA(0, 0), cA, voffA); PG8_STAGE(PG8_SA(0, 1), cA + hA, voffA);
    if (wr == 1) PG8_BAR;
    PG8_WAIT_V(2); PG8_BAR;
    PG8_STAGE(PG8_SB(1, 0), cB + kstep, voffB); PG8_STAGE(PG8_SA(1, 0), cA + kstep, voffA); PG8_STAGE(PG8_SB(1, 1), cB + hB + kstep, voffB);
    PG8_WAIT_V(6); PG8_BAR;
    for (;;) {
        const bool has_next = S.next(ui + 1, nxt);
        const char* nA = has_next ? (const char*)g.A + ((size_t)nxt.pm * BM * g.lda + (size_t)(nxt.pn / g.a_div) * g.a_koff) * 2 : cA;
        const char* nB = has_next ? (const char*)g.Bt + (size_t)nxt.pn * BM * g.ldb * 2 : cB;
        for (int t = 0; t < nt; t += 2) {
            const bool last = (t == nt - 2);
            const char* a1 = cA + (size_t)(t + 1) * kstep;
            const char* a2 = last ? nA : cA + (size_t)(t + 2) * kstep; const char* b2 = last ? nB : cB + (size_t)(t + 2) * kstep;
            const char* a3 = a2 + kstep; const char* b3 = b2 + kstep;
            PG8_LDB(B0, 0, 0); PG8_LDB(B1, 0, 1); PG8_SCHED; PG8_LDA(At, 0, 0); PG8_STAGE(PG8_SA(1, 1), a1 + hA, voffA);
            PG8_WAIT_V(8); PG8_WAIT_L(0); PG8_BAR; PG8_MMA(0, 0, At, B0); PG8_MMA(0, 1, At, B1); PG8_BAR; PG8_SCHED;
            PG8_LDA(At, 0, 1); PG8_STAGE(PG8_SB(0, 0), b2, voffB); PG8_STAGE(PG8_SB(0, 1), b2 + hB, voffB); PG8_STAGE(PG8_SA(0, 0), a2, voffA);
            PG8_WAIT_V(8); PG8_WAIT_L(0); PG8_BAR; PG8_MMA(1, 0, At, B0); PG8_MMA(1, 1, At, B1); PG8_BAR; PG8_SCHED;
            PG8_LDB(B0, 1, 0); PG8_LDB(B1, 1, 1); PG8_SCHED; PG8_LDA(At, 1, 0); PG8_STAGE(PG8_SA(0, 1), a2 + hA, voffA);
            PG8_WAIT_V(8); PG8_WAIT_L(0); PG8_BAR; PG8_MMA(0, 0, At, B0); PG8_MMA(0, 1, At, B1); PG8_BAR; PG8_SCHED;
            PG8_LDA(At, 1, 1); PG8_STAGE(PG8_SB(1, 0), b3, voffB); PG8_STAGE(PG8_SB(1, 1), b3 + hB, voffB); PG8_STAGE(PG8_SA(1, 0), a3, voffA);
            PG8_WAIT_V(8); PG8_WAIT_L(0); PG8_BAR; PG8_MMA(1, 0, At, B0); PG8_MMA(1, 1, At, B1); PG8_BAR; PG8_SCHED;
        }
        if (wr == 0) PG8_BAR;
        if constexpr (FP8) asm volatile("s_nop 15\n\ts_nop 7" ::: "memory");
        E(acc, cur, wr, wc, fr, fq);
        PG8_WAIT_L(0);
        if (!has_next) break;
#pragma unroll
        for (int a = 0; a < 2; ++a)
#pragma unroll
            for (int b = 0; b < 2; ++b)
#pragma unroll
                for (int m = 0; m < 4; ++m)
#pragma unroll
                    for (int n = 0; n < 2; ++n) acc[a][b][m][n] = (f32x4){0.f, 0.f, 0.f, 0.f};
        cur = nxt; cA = nA; cB = nB; ++ui;
        if (wr == 1) PG8_BAR;
    }
    PG8_WAIT_V(0);
    PG8_BAR;
#undef PG8_SA
#undef PG8_SB
#undef PG8_STAGE
#undef PG8_LDA
#undef PG8_LDB
#undef PG8_MMA
#undef PG8_WAIT_V
#undef PG8_WAIT_L
#undef PG8_BAR
#undef PG8_SCHED
}
}

struct Args { const float* in[23]; float* out; unsigned char* ws; int ph_lo, ph_hi, li, pad; };

typedef const __attribute__((address_space(4))) char* kargp_t;
struct Frame {
    LAS unsigned char* lds;
    int tid, lane, wave, G, bx;
    unsigned char* ws;
    kargp_t ka;
    __device__ __forceinline__ const float* in(int k) const { return *(const float* const __attribute__((address_space(4)))*)(ka + 8 * k); }
    __device__ __forceinline__ float* out() const { return *(float* const __attribute__((address_space(4)))*)(ka + 8 * 23); }
};
__device__ __forceinline__ Frame make_frame(LAS unsigned char* lds, int wv) {
    Frame F; F.lds = lds;
    asm volatile("" : "+s"(wv)); wv &= NWAVES - 1; const int ln = lane_now() & 63; F.tid = wv * 64 + ln; F.lane = ln; F.wave = wv;
    int g = gridDim.x, b = blockIdx.x; asm volatile("" : "+s"(g), "+s"(b)); F.G = g; F.bx = b;
    kargp_t ka = (kargp_t)__builtin_amdgcn_kernarg_segment_ptr(); asm volatile("" : "+s"(ka)); F.ka = ka;
    F.ws = *(unsigned char* const __attribute__((address_space(4)))*)(ka + 8 * 24);
    return F;
}

template <bool FP8 = false>
__device__ __forceinline__ void tr_item(const float* src, int ldn, int nvalid, int k0, int n0, void* dstv, int ldk, int drow0, LAS float* scr, int lane, const float* ksc = nullptr) {
    float ld_[32];
#pragma unroll
    for (int i = 0; i < 32; ++i) { const int kk = 2 * i + (lane >> 5), nn = lane & 31; ld_[i] = (nn < nvalid) ? src[(size_t)(k0 + kk) * ldn + n0 + nn] : 0.f; }
    if (ksc) {
#pragma unroll
        for (int i = 0; i < 32; ++i) ld_[i] *= ksc[k0 + 2 * i + (lane >> 5)]; }
#pragma unroll
    for (int i = 0; i < 32; ++i) { const int kk = 2 * i + (lane >> 5), nn = lane & 31; scr[kk * 33 + nn] = ld_[i]; }
    LGKM_WAIT(); asm volatile("" ::: "memory");
    const int c = lane & 7;
#pragma unroll
    for (int j = 0; j < 4; ++j) { const int n = (lane >> 3) + 8 * j; const LAS float* s = scr + (8 * c) * 33 + n;
        if constexpr (FP8) { u32x2 o; o.x = cvt4_fp8(s[0 * 33] * W8_SCALE, s[1 * 33] * W8_SCALE, s[2 * 33] * W8_SCALE, s[3 * 33] * W8_SCALE); o.y = cvt4_fp8(s[4 * 33] * W8_SCALE, s[5 * 33] * W8_SCALE, s[6 * 33] * W8_SCALE, s[7 * 33] * W8_SCALE);
            if (n < nvalid) *(u32x2*)((unsigned char*)dstv + (size_t)(drow0 + n) * ldk + k0 + 8 * c) = o; }
        else { u32x4 o; o.x = cvtpk(s[0 * 33], s[1 * 33]); o.y = cvtpk(s[2 * 33], s[3 * 33]); o.z = cvtpk(s[4 * 33], s[5 * 33]); o.w = cvtpk(s[6 * 33], s[7 * 33]);
            if (n < nvalid) *(u32x4*)((bf16_t*)dstv + (size_t)(drow0 + n) * ldk + k0 + 8 * c) = o; } }
    LGKM_WAIT(); asm volatile("" ::: "memory");
}
template <int OUT, bool XF32>
__device__ __forceinline__ void add_norm_row(const void* xin, const bf16_t* delta, bf16_t* xout, const float* gain, void* orow, int lane) {
    f32x4 v[8]; float s = 0.f;
#pragma unroll
    for (int j = 0; j < 8; ++j) {
        if constexpr (XF32) v[j] = ((const f32x4*)xin)[lane + 64 * j];
        else { const u32x2 xw = ((const u32x2*)xin)[lane + 64 * j]; v[j] = (f32x4){__builtin_bit_cast(float, xw.x << 16), __builtin_bit_cast(float, xw.x & 0xffff0000u), __builtin_bit_cast(float, xw.y << 16), __builtin_bit_cast(float, xw.y & 0xffff0000u)}; }
        const u32x2 dw = ((const u32x2*)delta)[lane + 64 * j];
        v[j].x += __builtin_bit_cast(float, dw.x << 16); v[j].y += __builtin_bit_cast(float, dw.x & 0xffff0000u); v[j].z += __builtin_bit_cast(float, dw.y << 16); v[j].w += __builtin_bit_cast(float, dw.y & 0xffff0000u);
        s += (v[j].x * v[j].x + v[j].y * v[j].y) + (v[j].z * v[j].z + v[j].w * v[j].w); }
    if (xout) {
#pragma unroll
        for (int j = 0; j < 8; ++j) { u32x2 o; o.x = cvtpk(v[j].x, v[j].y); o.y = cvtpk(v[j].z, v[j].w); ((u32x2*)xout)[lane + 64 * j] = o; } }
    const float rstd = 1.0f / sqrtf(wave_sum(s) * (1.0f / D) + EPS);
    if constexpr (OUT == 3) { if (lane == 0) *(float*)orow = rstd; return; }
#pragma unroll
    for (int j = 0; j < 8; ++j) { const f32x4 gv = ((const f32x4*)gain)[lane + 64 * j]; const f32x4 y = v[j] * rstd * gv;
        if constexpr (OUT == 0) ((unsigned*)orow)[lane + 64 * j] = cvt4_fp8(y.x, y.y, y.z, y.w);
        else if constexpr (OUT == 1) { u32x2 o; o.x = cvtpk(y.x, y.y); o.y = cvtpk(y.z, y.w); ((u32x2*)orow)[lane + 64 * j] = o; }
        else ((f32x4*)orow)[lane + 64 * j] = y; }
}
__device__ __forceinline__ void cast_row_rstd(const float* xrow, bf16_t* orow, float* rstd, int lane) {
    f32x4 v[8]; float s = 0.f;
#pragma unroll
    for (int j = 0; j < 8; ++j) { v[j] = ((const f32x4*)xrow)[lane + 64 * j]; s += (v[j].x * v[j].x + v[j].y * v[j].y) + (v[j].z * v[j].z + v[j].w * v[j].w); }
#pragma unroll
    for (int j = 0; j < 8; ++j) { u32x2 o; o.x = cvtpk(v[j].x, v[j].y); o.y = cvtpk(v[j].z, v[j].w); ((u32x2*)orow)[lane + 64 * j] = o; }
    const float r = 1.0f / sqrtf(wave_sum(s) * (1.0f / D) + EPS);
    if (lane == 0) *rstd = r;
}
__device__ __forceinline__ void rms_row_bf16(const float* xrow, const float* gain, bf16_t* orow, int lane) {
    f32x4 v[8]; float s = 0.f;
#pragma unroll
    for (int j = 0; j < 8; ++j) { v[j] = ((const f32x4*)xrow)[lane + 64 * j]; s += (v[j].x * v[j].x + v[j].y * v[j].y) + (v[j].z * v[j].z + v[j].w * v[j].w); }
    const float rstd = 1.0f / sqrtf(wave_sum(s) * (1.0f / D) + EPS);
#pragma unroll
    for (int j = 0; j < 8; ++j) { const f32x4 gv = ((const f32x4*)gain)[lane + 64 * j];
        u32x2 o; o.x = cvtpk(v[j].x * rstd * gv.x, v[j].y * rstd * gv.y); o.y = cvtpk(v[j].z * rstd * gv.z, v[j].w * rstd * gv.w);
        ((u32x2*)orow)[lane + 64 * j] = o; }
}
__device__ __forceinline__ void qabs_fold_unit(const Frame& F, const float* w_uq, const float* w_uk, bf16_t* btq, int unit) {
    const int j = unit / 384, r = unit % 384, h = r / 32, cb = (r % 32) / 8, kb = r % 8, c0 = cb * 64, k0 = kb * 64;
    LAS float* Aw = (LAS float*)F.lds; LAS float* Bw = Aw + 64 * 132;
    const float* ukb = w_uk + (((size_t)j * NH + h) * KVL + c0) * HD;
    const float* uqb = w_uq + ((size_t)j * QL + k0) * (NH * HD) + h * HD;
#pragma unroll
    for (int i = 0; i < 4; ++i) { const int idx = F.tid + 512 * i, row = idx >> 5, c4 = idx & 31;
        const f32x4 a = *(const f32x4*)(ukb + (size_t)row * HD + 4 * c4), b = *(const f32x4*)(uqb + (size_t)row * (NH * HD) + 4 * c4);
        *(LAS f32x4*)(Aw + row * 132 + 4 * c4) = a; *(LAS f32x4*)(Bw + row * 132 + 4 * c4) = b; }
    __syncthreads();
    const int c = F.lane, kg = F.wave;
    float acc[8];
#pragma unroll
    for (int e = 0; e < 8; ++e) acc[e] = 0.f;
#pragma unroll 4
    for (int d = 0; d < HD; d += 4) { const f32x4 a = *(const LAS f32x4*)(Aw + c * 132 + d);
#pragma unroll
        for (int e = 0; e < 8; ++e) { const f32x4 bv = *(const LAS f32x4*)(Bw + (kg * 8 + e) * 132 + d); acc[e] += (a.x * bv.x + a.y * bv.y) + (a.z * bv.z + a.w * bv.w); } }
    const float sc = 0.08838834764831845f;
    u32x4 o; o.x = cvtpk(acc[0] * sc, acc[1] * sc); o.y = cvtpk(acc[2] * sc, acc[3] * sc); o.z = cvtpk(acc[4] * sc, acc[5] * sc); o.w = cvtpk(acc[6] * sc, acc[7] * sc);
    *(u32x4*)(btq + (size_t)j * NQ * QL + (size_t)(h * KVL + c0 + c) * QL + k0 + kg * 8) = o;
    __syncthreads();
}

__device__ __forceinline__ void phase_prologue(const Frame& F) {
    unsigned char* ws = F.ws;
    const float* x = F.in(0); const float* mem = F.in(1); const float* mixer_norm = F.in(2); const float* mem_norm = F.in(5);
    const float* w_mem_kv = F.in(6); const float* w_out = F.in(7); const float* w_gate = F.in(8); const float* w_up = F.in(9); const float* w_down = F.in(10);
    const float* w_in_attn = F.in(11); const float* w_uq = F.in(14); const float* w_uk = F.in(15); const float* w_uv = F.in(16); const float* w_idx_uq = F.in(17);
    const float* w_in_pool = F.in(20); const float* w_pool_group = F.in(21); const float* pool_scale = F.in(22);
    for (int u = F.bx; u < 768; u += F.G) qabs_fold_unit(F, w_uq, w_uk, (bf16_t*)(ws + WS_BT_Q), u);
    __syncthreads();
    LAS float* scr = (LAS float*)(F.lds + F.wave * 16384);
    const int gw = F.bx * NWAVES + F.wave, NGW = F.G * NWAVES;
    constexpr int I_G = (D / 64) * (DFF / 32), I_DN = (DFF / 64) * (D / 32), I_O = (D / 64) * (D / 32), I_MKV = (D / 64) * (1024 / 32);
    constexpr int I_IA = (D / 64) * 43, I_IQ = (QL / 64) * (1024 / 32), I_IP = (D / 64) * (D / 32);
    constexpr int PER_L = 2 * I_G + I_DN + I_O + I_MKV, PER_J = I_IA + I_IQ + I_IP;
    constexpr int NITEMS = 4 * PER_L + 2 * PER_J;
    for (int it = gw; it < NITEMS; it += NGW) {
        int r = it;
        if (r < 4 * PER_L) {
            const int l = r / PER_L; r -= l * PER_L;
            if (r < 2 * I_G) { const int up = r >= I_G; if (up) r -= I_G; const float* W = (up ? w_up : w_gate) + (size_t)l * D * DFF;
                const int nblk = DFF / 32, kb = r / nblk, nb = r % nblk, n0 = 32 * nb;
                tr_item<true>(W, DFF, 32, 64 * kb, n0, (unsigned char*)(ws + WS_BT_GU) + (size_t)l * SZ_BT_GU, D, 256 * (n0 / 128) + (n0 % 128) + (up ? 128 : 0), scr, F.lane, F.in(3) + (size_t)l * D); continue; }
            r -= 2 * I_G;
            if (r < I_DN) { const int nblk = D / 32, kb = r / nblk, nb = r % nblk;
                tr_item<true>(w_down + (size_t)l * DFF * D, D, 32, 64 * kb, 32 * nb, (unsigned char*)(ws + WS_BT_DOWN) + (size_t)l * D * DFF, DFF, 32 * nb, scr, F.lane); continue; }
            r -= I_DN;
            if (r < I_O) { const int nblk = D / 32, kb = r / nblk, nb = r % nblk;
                if (l & 1) { if (64 * kb < PW) tr_item(w_out + (size_t)l * D * D, D, 32, 64 * kb, 32 * nb, (bf16_t*)(ws + WS_BT_OUTT) + (size_t)(l >> 1) * PW, 2 * PW, 32 * nb, scr, F.lane);
                    else tr_item(w_out + (size_t)l * D * D, D, 32, 64 * kb, 32 * nb, (bf16_t*)(ws + WS_BT_OUT + (size_t)l * SZ_BT_OUT), D, 32 * nb, scr, F.lane); }
                else { if (64 * kb < PW) tr_item(w_out + (size_t)l * D * D, D, 32, 64 * kb, 32 * nb, (bf16_t*)(ws + WS_BT_OUTTD) + (size_t)(l >> 1) * PW, 2 * PW, 32 * nb, scr, F.lane);
                    else tr_item<true>(w_out + (size_t)l * D * D, D, 32, 64 * kb, 32 * nb, (unsigned char*)(ws + WS_BT_OUT + (size_t)l * SZ_BT_OUT) + (QABS_W_ - PW), YW8, 32 * nb, scr, F.lane); }
                continue; }
            r -= I_O;
            { const int nblk = 1024 / 32, kb = r / nblk, nb = r % nblk;
                tr_item(w_mem_kv + (size_t)l * D * 1024, 1024, 32, 64 * kb, 32 * nb, (bf16_t*)(ws + WS_BT_MEMKV), D, l * 1024 + 32 * nb, scr, F.lane); continue; }
        }
        r -= 4 * PER_L;
        const int j = r / PER_J; r -= j * PER_J;
        if (r < I_IA) { const int kb = r / 43, nb = r % 43, n0 = 32 * nb; const int nv = (ATTN_IN - n0) < 32 ? (ATTN_IN - n0) : 32;
            tr_item(w_in_attn + (size_t)j * D * ATTN_IN, ATTN_IN, nv, 64 * kb, n0, (bf16_t*)(ws + WS_BT_INATTN) + (size_t)j * ATTN_IN_PAD * D, D, n0, scr, F.lane, mixer_norm + (size_t)(2 * j) * D); continue; }
        r -= I_IA;
        if (r < I_IQ) { const int nblk = 1024 / 32, kb = r / nblk, nb = r % nblk;
            tr_item(w_idx_uq + (size_t)j * QL * 1024, 1024, 32, 64 * kb, 32 * nb, (bf16_t*)(ws + WS_BT_Q) + (size_t)j * NQ * QL, QL, QABS_W + 32 * nb, scr, F.lane); continue; }
        r -= I_IQ;
        { const int nblk = D / 32, kb = r / nblk, nb = r % nblk;
            tr_item(w_in_pool + (size_t)j * D * D, D, 32, 64 * kb, 32 * nb, (bf16_t*)(ws + WS_BT_INPOOL) + (size_t)j * D * D, D, 32 * nb, scr, F.lane, mixer_norm + (size_t)(2 * j + 1) * D); }
    }
    const size_t gt = (size_t)F.bx * 512 + F.tid, GT = (size_t)F.G * 512;
    for (size_t i = gt; i < (size_t)2 * NH * KVL * HD / 8; i += GT) {
        const f32x4 a = ((const f32x4*)w_uv)[2 * i], b = ((const f32x4*)w_uv)[2 * i + 1];
        u32x4 o; o.x = cvtpk(a.x, a.y); o.y = cvtpk(a.z, a.w); o.z = cvtpk(b.x, b.y); o.w = cvtpk(b.z, b.w);
        ((u32x4*)(ws + WS_BT_UV))[i] = o;
    }
    for (size_t i = gt; i < (size_t)2 * 2048 * 48; i += GT) {
        const int j = (int)(i / (2048 * 48)), rem = (int)(i % (2048 * 48)), row = rem / 48, k8 = (rem % 48) * 8;
        const int pn = row / 256, rr = row % 256, g = pn >> 1, c384 = 256 * (pn & 1) + rr;
        float v[8];
#pragma unroll
        for (int e = 0; e < 8; ++e) v[e] = (c384 < PGW) ? w_pool_group[(((size_t)j * 4 + g) * PGW + c384) * PGW + (k8 + e)] * pool_scale[j * PW + g * PGW + k8 + e] : 0.f;
        u32x4 o; o.x = cvtpk(v[0], v[1]); o.y = cvtpk(v[2], v[3]); o.z = cvtpk(v[4], v[5]); o.w = cvtpk(v[6], v[7]);
        *(u32x4*)((bf16_t*)(ws + WS_BT_GROUP) + (size_t)j * 2048 * PGW + (size_t)row * PGW + k8) = o;
    }
    for (size_t i = gt; i < (size_t)2 * (ATTN_IN_PAD - ATTN_IN) * (D / 8); i += GT) {
        const int j = (int)(i / ((ATTN_IN_PAD - ATTN_IN) * (D / 8))), rem = (int)(i % ((ATTN_IN_PAD - ATTN_IN) * (D / 8))), row = ATTN_IN + rem / (D / 8), k8 = (rem % (D / 8)) * 8;
        *(u32x4*)((bf16_t*)(ws + WS_BT_INATTN) + (size_t)j * ATTN_IN_PAD * D + (size_t)row * D + k8) = (u32x4){0u, 0u, 0u, 0u};
    }
    for (int m = gw; m < 1024; m += NGW) rms_row_bf16(mem + (size_t)m * D, mem_norm, (bf16_t*)(ws + WS_MEMN) + (size_t)m * D, F.lane);
    for (int m = gw; m < M; m += NGW) cast_row_rstd(x + (size_t)m * D, (bf16_t*)(ws + WS_XRES) + (size_t)m * D, (float*)(ws + WS_RSTD) + m, F.lane);
}

__device__ __forceinline__ void phase_postproj(const Frame& F, const float* q_norm, const float* kv_norm, const float* ikn, const float* ikb) {
    unsigned char* ws = F.ws;
    const float* proj = (const float*)(ws + WS_R0);
    const int gw = F.bx * NWAVES + F.wave, NGW = F.G * NWAVES, lane = F.lane;
    const f32x4 ga = ((const f32x4*)q_norm)[lane], gb = ((const f32x4*)q_norm)[lane + 64], gk = ((const f32x4*)kv_norm)[lane];
    const float gi = ikn[lane], bi = ikb[lane];
    for (int m = gw; m < M; m += NGW) {
        const float* p = proj + (size_t)m * ATTN_IN_PAD;
        const f32x4 a = ((const f32x4*)p)[lane], b = ((const f32x4*)p)[lane + 64], c = ((const f32x4*)(p + 512))[lane];
        const float kv = p[768 + lane];
        const f32x4 qa = ((const f32x4*)(p + 848))[lane], qb = ((const f32x4*)(p + 848))[lane + 64];
        const float wraw = p[832 + (lane & (IH - 1))];
        float r0 = (a.x * a.x + a.y * a.y) + (a.z * a.z + a.w * a.w) + (b.x * b.x + b.y * b.y) + (b.z * b.z + b.w * b.w);
        float r1 = (c.x * c.x + c.y * c.y) + (c.z * c.z + c.w * c.w), r2 = kv, r3 = kv * kv;
#pragma unroll
        for (int o = 1; o < 64; o <<= 1) { const float t0 = __shfl_xor(r0, o), t1 = __shfl_xor(r1, o), t2 = __shfl_xor(r2, o), t3 = __shfl_xor(r3, o); r0 += t0; r1 += t1; r2 += t2; r3 += t3; }
        const float rq = 1.0f / sqrtf(r0 * (1.0f / QL) + EPS), rk = 1.0f / sqrtf(r1 * (1.0f / KVL) + EPS);
        const float mu = r2 * (1.0f / IDM), var = fmaxf(r3 * (1.0f / IDM) - mu * mu, 0.f), ri = 1.0f / sqrtf(var + EPS);
        { u32x2 o0, o1; o0.x = cvtpk(a.x * rq * ga.x, a.y * rq * ga.y); o0.y = cvtpk(a.z * rq * ga.z, a.w * rq * ga.w);
          o1.x = cvtpk(b.x * rq * gb.x, b.y * rq * gb.y); o1.y = cvtpk(b.z * rq * gb.z, b.w * rq * gb.w);
          u32x2* o = (u32x2*)((bf16_t*)(ws + WS_CQN) + (size_t)m * QL); o[lane] = o0; o[lane + 64] = o1; }
        ((unsigned*)(ws + WS_CKV + (size_t)m * KVL))[lane] = cvt4_fp8(c.x * rk * gk.x, c.y * rk * gk.y, c.z * rk * gk.z, c.w * rk * gk.w);
        { const float y = (kv - mu) * ri * gi + bi; const unsigned pk = cvtpk(y, y);
          ((bf16_t*)(ws + WS_KIDX))[(size_t)(m >> 5) * 2048 + ((lane >> 3) * 32 + (m & 31)) * 8 + (lane & 7)] = (bf16_t)(pk & 0xffffu); }
        if (lane < IH) ((float*)(ws + WS_WIDX))[(size_t)m * IH + lane] = wraw * 0.03125f;
        { u32x2 o0, o1; o0.x = cvtpk(qa.x, qa.y); o0.y = cvtpk(qa.z, qa.w); o1.x = cvtpk(qb.x, qb.y); o1.y = cvtpk(qb.z, qb.w);
          u32x2* o = (u32x2*)((bf16_t*)(ws + WS_QMEM) + (size_t)m * MW); o[lane] = o0; o[lane + 64] = o1; }
    }
}

__device__ __forceinline__ float relu1(float x) { return __builtin_amdgcn_fmed3f(x, 0.0f, __builtin_inff()); }
__device__ __forceinline__ float xhalf_sum(float x) {
    const u32x2 r = __builtin_amdgcn_permlane32_swap(__builtin_bit_cast(unsigned, x), __builtin_bit_cast(unsigned, x), false, false);
    return __builtin_bit_cast(float, r[0]) + __builtin_bit_cast(float, r[1]);
}
__device__ __forceinline__ unsigned ordkey(float f) { const unsigned b = __builtin_bit_cast(unsigned, f); return (b & 0x80000000u) ? ~b : (b | 0x80000000u); }
__device__ __forceinline__ unsigned mbcnt64(unsigned long long m) { return __builtin_amdgcn_mbcnt_hi((unsigned)(m >> 32), __builtin_amdgcn_mbcnt_lo((unsigned)m, 0u)); }
__device__ __forceinline__ unsigned kvoff(unsigned row, unsigned ch) { return row * 512u + ((ch ^ (row & 15u)) << 4); }

__device__ __forceinline__ void phase_dsa(const Frame& F, bool dummy) {
    unsigned char* ws = F.ws;
    const bf16_t* qidx = (const bf16_t*)(ws + WS_R0 + R0_B);
    const bf16_t* kidx = (const bf16_t*)(ws + WS_KIDX);
    const float* widx = (const float*)(ws + WS_WIDX);
    bf16_t* qabs = (bf16_t*)(ws + WS_R0);
    const int lane = F.lane, wave = F.wave, l31 = lane & 31, h5 = lane >> 5, l15 = lane & 15, g4 = lane >> 4;
    LAS float* scores = (LAS float*)F.lds;
    LAS unsigned short* idxl = (LAS unsigned short*)(F.lds + LDS_IDX_OFF) + wave * IDX_STRIDE;
    LAS unsigned char* region = F.lds + wave * 16384;
    const unsigned region_a = (unsigned)(size_t)region;
    for (int ui = 0; ; ++ui) {
        const int unit = ui * F.G + ((ui & 1) ? ((F.G - 1 - F.bx) & ~3) | (F.bx & 3) : F.bx); if (unit >= M / 8) break;
        const int b = unit & 3, tb = unit >> 2, t0 = tb * 8, tok0 = b * T + t0;
        __syncthreads();
        for (int rp1 = 0; rp1 < (DSA_PROBE == 1 ? 2 : 1); ++rp1) {
            const int nkt = (t0 + 8 + 31) >> 5;
            const bf16_t* kb = kidx + (size_t)(b * T) * IDM + (h5 * 32 + l31) * 8;
            bf16x8 aq[4][4]; float wv[4][16];
#pragma unroll
            for (int rg = 0; rg < 4; ++rg) {
                const int q0 = tok0 + 2 * rg;
#pragma unroll
                for (int ks = 0; ks < 4; ++ks) aq[rg][ks] = *(const bf16x8*)(qidx + (size_t)(q0 + (l31 >> 4)) * 1024 + l15 * 64 + 16 * ks + 8 * h5);
#pragma unroll
                for (int qq = 0; qq < 2; ++qq)
#pragma unroll
                    for (int hh = 0; hh < 2; ++hh) { const f32x4 w4 = *(const f32x4*)(widx + (size_t)(q0 + qq) * IH + 8 * hh + 4 * h5);
                        wv[rg][8 * qq + 4 * hh + 0] = w4.x; wv[rg][8 * qq + 4 * hh + 1] = w4.y; wv[rg][8 * qq + 4 * hh + 2] = w4.z; wv[rg][8 * qq + 4 * hh + 3] = w4.w; }
            }
            bf16x8 bk[4];
            { const int kt0 = wave < nkt ? wave : 0;
#pragma unroll
              for (int ks = 0; ks < 4; ++ks) bk[ks] = *(const bf16x8*)(kb + (size_t)kt0 * 2048 + 512 * ks); }
            for (int kt = wave; kt < nkt; kt += NWAVES) {
                bf16x8 bn[4];
                const int ktn = (kt + NWAVES < nkt) ? kt + NWAVES : kt;
#pragma unroll
                for (int ks = 0; ks < 4; ++ks) bn[ks] = *(const bf16x8*)(kb + (size_t)ktn * 2048 + 512 * ks);
#pragma unroll
                for (int hp = 0; hp < 2; ++hp) {
                    f32x16 acc[2];
#pragma unroll
                    for (int rg = 0; rg < 2; ++rg) {
#pragma unroll
                        for (int r = 0; r < 16; ++r) acc[rg][r] = 0.f;
#pragma unroll
                        for (int ks = 0; ks < 4; ++ks) acc[rg] = __builtin_amdgcn_mfma_f32_32x32x16_bf16(aq[2 * hp + rg][ks], bk[ks], acc[rg], 0, 0, 0);
                    }
                    float sA[2], sB[2];
#pragma unroll
                    for (int rg = 0; rg < 2; ++rg) { sA[rg] = 0.f; sB[rg] = 0.f;
#pragma unroll
                        for (int r = 0; r < 8; ++r) { sA[rg] += wv[2 * hp + rg][r] * relu1(acc[rg][r]); sB[rg] += wv[2 * hp + rg][8 + r] * relu1(acc[rg][8 + r]); } }
                    const float tA0 = __shfl_xor(sA[0], 32), tB0 = __shfl_xor(sB[0], 32), tA1 = __shfl_xor(sA[1], 32), tB1 = __shfl_xor(sB[1], 32);
                    scores[(4 * hp + h5) * 4096 + 32 * kt + l31] = h5 ? sB[0] + tB0 : sA[0] + tA0;
                    scores[(4 * hp + 2 + h5) * 4096 + 32 * kt + l31] = h5 ? sB[1] + tB1 : sA[1] + tA1;
                }
#pragma unroll
                for (int ks = 0; ks < 4; ++ks) bk[ks] = bn[ks];
            }
        }
        __syncthreads();
        const int t = t0 + wave, tok = tok0 + wave, nvalid = t + 1, cnt = nvalid < TOPK ? nvalid : TOPK;
        for (int rp2 = 0; rp2 < (DSA_PROBE == 2 ? 2 : 1); ++rp2)
        if (nvalid <= TOPK) {
#pragma unroll
            for (int i = 0; i < 4; ++i) { const int j = lane + 64 * i; idxl[j] = (unsigned short)(j <= t ? j : 0); }
        } else {
            unsigned u[64];
            int ln2 = F.lane; asm volatile("" : "+v"(ln2));
#pragma unroll
            for (int g8 = 0; g8 < 8; ++g8) {
                if (64 * 8 * g8 <= t) {
#pragma unroll
                    for (int i = 8 * g8; i < 8 * g8 + 8; ++i) { const int j = 64 * i + ln2; const float sv = scores[wave * 4096 + j]; u[i] = (j <= t) ? ordkey(sv) : 0u; }
                } else {
#pragma unroll
                    for (int i = 8 * g8; i < 8 * g8 + 8; ++i) u[i] = 0u;
                } }
            unsigned kmx = 0u, kmn = 0xffffffffu;
#pragma unroll
            for (int g8 = 0; g8 < 8; ++g8) if (64 * 8 * g8 <= t) {
#pragma unroll
                for (int i = 8 * g8; i < 8 * g8 + 8; ++i) { kmx = u[i] > kmx ? u[i] : kmx; const unsigned v = u[i] ? u[i] : 0xffffffffu; kmn = v < kmn ? v : kmn; } }
#pragma unroll
            for (int o = 1; o < 64; o <<= 1) { const unsigned a = (unsigned)__shfl_xor((int)kmx, o), bb = (unsigned)__shfl_xor((int)kmn, o); kmx = a > kmx ? a : kmx; kmn = bb < kmn ? bb : kmn; }
            unsigned lo = __builtin_amdgcn_readfirstlane(kmn), hi = __builtin_amdgcn_readfirstlane(kmx) + 1u, Tk = lo;
            int clo = nvalid, chi = 0, side = 0;
            for (int it = 0; it < 128 && hi - lo > 1u; ++it) {
                const unsigned blo = (lo & 0x80000000u) ? (lo ^ 0x80000000u) : ~lo, bhi = (hi & 0x80000000u) ? (hi ^ 0x80000000u) : ~hi;
                const float flo = __builtin_bit_cast(float, blo), fhi = __builtin_bit_cast(float, bhi);
                float wa = (float)clo - ((float)TOPK - 0.5f), wb = ((float)TOPK - 0.5f) - (float)chi;
                if (side >= 2) wb *= 0.5f; if (side <= -2) wa *= 0.5f;
                const float frac = it ? wa / (wa + wb) : 0.443f + 0.067f * ((float)(31 - __clz(nvalid)) - 7.5f);
                const float fc = flo + (fhi - flo) * frac;
                unsigned cand = ordkey(fc);
                cand = (cand <= lo || !(fc == fc)) ? lo + 1u : cand; cand = cand >= hi ? hi - 1u : cand;
                cand = (unsigned)__builtin_amdgcn_readfirstlane((int)cand);
                int c = 0;
#pragma unroll
                for (int g8 = 0; g8 < 8; ++g8) if (64 * 8 * g8 <= t) {
#pragma unroll
                    for (int i = 8 * g8; i < 8 * g8 + 8; ++i) c += __popcll(__ballot(u[i] >= cand));
                    __builtin_amdgcn_sched_barrier(0);
                }
                if (c >= TOPK) { lo = cand; clo = c; side = side > 0 ? side + 1 : 1; } else { hi = cand; chi = c; side = side < 0 ? side - 1 : -1; }
                if (c == TOPK) break;
            }
            Tk = lo;
            if (clo != TOPK && hi - lo > 1u) {
                Tk = 0u;
                for (int bit = 31; bit >= 0; --bit) {
                    const unsigned cand = Tk | (1u << bit); int c = 0;
#pragma unroll
                    for (int g8 = 0; g8 < 8; ++g8) if (64 * 8 * g8 <= t) {
#pragma unroll
                        for (int i = 8 * g8; i < 8 * g8 + 8; ++i) c += __popcll(__ballot(u[i] >= cand));
                        __builtin_amdgcn_sched_barrier(0);
                    }
                    if (c >= TOPK) Tk = cand;
                    if (c == TOPK) break;
                }
            }
            if (clo == TOPK) {
                int ln2c = F.lane; asm volatile("" : "+v"(ln2c));
                unsigned Tk3 = __builtin_amdgcn_readfirstlane(Tk); asm volatile("" : "+s"(Tk3));
                int base = 0;
#pragma unroll
                for (int g8 = 0; g8 < 8; ++g8) if (64 * 8 * g8 <= t) {
#pragma unroll
                    for (int i = 8 * g8; i < 8 * g8 + 8; ++i) {
                        const bool sel = u[i] >= Tk3; const unsigned long long mk = __ballot(sel);
                        const int pos = __builtin_amdgcn_mbcnt_hi((unsigned)(mk >> 32), __builtin_amdgcn_mbcnt_lo((unsigned)mk, (unsigned)base));
                        idxl[sel ? pos : TOPK + ln2c] = (unsigned short)(64 * i + ln2c);
                        base += __popcll(mk);
                    }
                    __builtin_amdgcn_sched_barrier(0);
                }
            } else {
                int cg = 0, ce = 0;
    #pragma unroll
                for (int g8 = 0; g8 < 8; ++g8) if (64 * 8 * g8 <= t) {
    #pragma unroll
                    for (int i = 8 * g8; i < 8 * g8 + 8; ++i) { cg += (u[i] > Tk) ? 1 : 0; ce += (u[i] == Tk) ? 1 : 0; } }
                int Pg = cg, Pe = ce;
    #pragma unroll
                for (int o = 1; o < 64; o <<= 1) { const int tg = __shfl_up(Pg, o), te = __shfl_up(Pe, o); if (lane >= o) { Pg += tg; Pe += te; } }
                int ln2b = F.lane; asm volatile("" : "+v"(ln2b));
                unsigned Tk2 = __builtin_amdgcn_readfirstlane(Tk); asm volatile("" : "+s"(Tk2));
                const int ngt = __builtin_amdgcn_readlane(Pg, 63), kk = TOPK - ngt;
                int pos_g = Pg - cg, pos_e = ngt + (Pe - ce);
    #pragma unroll
                for (int g8 = 0; g8 < 8; ++g8) if (64 * 8 * g8 <= t) {
    #pragma unroll
                    for (int i = 8 * g8; i < 8 * g8 + 8; ++i) {
                        const bool g = u[i] > Tk2, e = u[i] == Tk2;
                        const int trash = TOPK + ln2b;
                        idxl[(g && pos_g < TOPK) ? pos_g : ((e && pos_e < TOPK) ? pos_e : trash)] = (unsigned short)(64 * i + ln2b);
                        pos_g += g ? 1 : 0; pos_e += e ? 1 : 0;
                    } }
                    }
        }
        LGKM_WAIT();
        for (int rp3 = 0; rp3 < (DSA_PROBE == 3 ? 2 : 1); ++rp3) {
            int ln3 = F.lane; asm volatile("" : "+v"(ln3));
            const int lane = ln3, l31 = lane & 31, h5 = lane >> 5, l15 = lane & 15, g4 = lane >> 4;
            const bf16_t* qrow = qabs + (size_t)tok * QABS_W + l15 * KVL + 32 * g4;
            i32x8 bq8[2];
#pragma unroll
            for (int s = 0; s < 2; ++s) { int w8[8];
#pragma unroll
                for (int e = 0; e < 4; ++e) { u32x4 qw = (u32x4){0u, 0u, 0u, 0u}; if (l15 < NH) qw = *(const u32x4*)(qrow + 128 * s + 8 * e);
                    w8[2 * e] = (int)cvt4_fp8(__builtin_bit_cast(float, qw.x << 16) * QA8_SCALE, __builtin_bit_cast(float, qw.x & 0xffff0000u) * QA8_SCALE, __builtin_bit_cast(float, qw.y << 16) * QA8_SCALE, __builtin_bit_cast(float, qw.y & 0xffff0000u) * QA8_SCALE);
                    w8[2 * e + 1] = (int)cvt4_fp8(__builtin_bit_cast(float, qw.z << 16) * QA8_SCALE, __builtin_bit_cast(float, qw.z & 0xffff0000u) * QA8_SCALE, __builtin_bit_cast(float, qw.w << 16) * QA8_SCALE, __builtin_bit_cast(float, qw.w & 0xffff0000u) * QA8_SCALE); }
                bq8[s] = (i32x8){w8[0], w8[1], w8[2], w8[3], w8[4], w8[5], w8[6], w8[7]}; }
            f32x4 o[16];
#pragma unroll
            for (int ct = 0; ct < 16; ++ct) o[ct] = (f32x4){0.f, 0.f, 0.f, 0.f};
            float m_run = -INFINITY, l_run = 0.f;
            const unsigned char* ckvb = (const unsigned char*)(ws + WS_CKV) + (size_t)b * T * KVL;
            const int nch = (cnt + 31) >> 5;
#define DSA_GATHER(CH, BUF) do { const u32x4 kw_ = *(const LAS u32x4*)(idxl + (CH) * 32 + g4 * 8); const unsigned kk_[4] = {kw_.x, kw_.y, kw_.z, kw_.w}; \
                _Pragma("unroll") for (int i = 0; i < 8; ++i) { const unsigned key = (i & 1) ? (kk_[i >> 1] >> 16) : (kk_[i >> 1] & 0xffffu); \
                    const unsigned char* src_ = ckvb + (size_t)(key * (unsigned)KVL) + ((((unsigned)l15) ^ ((unsigned)(4 * i + g4) & 15u)) << 4); \
                    __builtin_amdgcn_global_load_lds((const unsigned*)src_, (LAS unsigned*)(region + (BUF) * 8192 + i * 1024), 16, 0, 0); } } while (0)
            const unsigned qr = ((unsigned)l15 >> 1) & 3u, r15 = 4u * g4 + qr;
            const unsigned trbase = region_a + (r15 + 16u * ((unsigned)l15 >> 3)) * 256u + 8u * ((unsigned)l15 & 1u);
            unsigned sa[4];
#pragma unroll
            for (int s = 0; s < 2; ++s)
#pragma unroll
                for (int e = 0; e < 2; ++e) sa[2 * s + e] = region_a + (unsigned)l15 * 256u + ((((unsigned)(8 * s + 2 * g4 + e)) ^ (unsigned)l15) << 4);
            LGKM_WAIT();
            DSA_GATHER(0, 0);
            for (int ch = 0; ch < nch; ++ch) {
                const unsigned cur = (unsigned)(ch & 1) * 8192u;
                if (ch + 1 < nch) { LGKM_WAIT(); DSA_GATHER(ch + 1, (ch + 1) & 1); asm volatile("s_waitcnt vmcnt(8)" ::: "memory"); }
                else asm volatile("s_waitcnt vmcnt(0)" ::: "memory");
                i32x4 ar[8];
#pragma unroll
                for (int s = 0; s < 2; ++s) {
                    const unsigned a0 = sa[2 * s] + cur, a1 = sa[2 * s + 1] + cur;
                    asm volatile("ds_read_b128 %0, %4\n\tds_read_b128 %1, %5\n\tds_read_b128 %2, %4 offset:4096\n\tds_read_b128 %3, %5 offset:4096"
                                 : "=&v"(ar[2 * s]), "=&v"(ar[2 * s + 1]), "=&v"(ar[4 + 2 * s]), "=&v"(ar[4 + 2 * s + 1]) : "v"(a0), "v"(a1) : "memory");
                }
                asm volatile("s_waitcnt lgkmcnt(0)" ::: "memory"); __builtin_amdgcn_sched_barrier(0);
                f32x4 st[2];
#pragma unroll
                for (int tl = 0; tl < 2; ++tl) { st[tl] = (f32x4){0.f, 0.f, 0.f, 0.f};
#pragma unroll
                    for (int s = 0; s < 2; ++s) { const i32x8 a8 = __builtin_shufflevector(ar[4 * tl + 2 * s], ar[4 * tl + 2 * s + 1], 0, 1, 2, 3, 4, 5, 6, 7);
                        asm volatile("s_nop 1\n\tv_mfma_f32_16x16x128_f8f6f4 %0, %1, %2, %0" : "+v"(st[tl]) : "v"(a8), "v"(bq8[s])); } }
                asm volatile("s_nop 15\n\ts_nop 3" ::: "memory"); __builtin_amdgcn_sched_barrier(0);
                float mx = -INFINITY;
#pragma unroll
                for (int tl = 0; tl < 2; ++tl)
#pragma unroll
                    for (int r = 0; r < 4; ++r) { const int pos = ch * 32 + r * 8 + 4 * tl + g4; st[tl][r] = (pos >= cnt) ? -INFINITY : st[tl][r] * (1.0f / QA8_SCALE); mx = fmaxf(mx, st[tl][r]); }
                if (__any(mx > m_run + 5.0f)) {
                    mx = fmaxf(mx, __shfl_xor(mx, 16)); mx = fmaxf(mx, __shfl_xor(mx, 32));
                    const float m_new = (mx > m_run + 5.0f) ? mx : m_run, alpha = __expf(m_run - m_new);
                    l_run *= alpha; m_run = m_new;
#pragma unroll
                    for (int ct = 0; ct < 16; ++ct) o[ct] *= alpha;
                }
                float p[8]; float ps = 0.f;
#pragma unroll
                for (int tl = 0; tl < 2; ++tl)
#pragma unroll
                    for (int r = 0; r < 4; ++r) { p[tl * 4 + r] = __expf(st[tl][r] - m_run); ps += p[tl * 4 + r]; }
                l_run += ps;
                const long bp = (long)(((unsigned long long)cvt4_fp8(p[4], p[5], p[6], p[7]) << 32) | (unsigned long long)cvt4_fp8(p[0], p[1], p[2], p[3]));
#pragma unroll
                for (int half = 0; half < 2; ++half) {
                    long vt[8];
#pragma unroll
                    for (int c = 0; c < 8; c += 4) {
                        unsigned ta[4];
#pragma unroll
                        for (int e = 0; e < 4; ++e) ta[e] = trbase + cur + ((((unsigned)(8 * half + c + e)) ^ r15) << 4);
                        asm volatile("ds_read_b64_tr_b8 %0, %4\n\tds_read_b64_tr_b8 %1, %5\n\tds_read_b64_tr_b8 %2, %6\n\tds_read_b64_tr_b8 %3, %7"
                                     : "=&v"(vt[c]), "=&v"(vt[c + 1]), "=&v"(vt[c + 2]), "=&v"(vt[c + 3]) : "v"(ta[0]), "v"(ta[1]), "v"(ta[2]), "v"(ta[3]) : "memory");
                    }
                    asm volatile("s_waitcnt lgkmcnt(0)" ::: "memory"); __builtin_amdgcn_sched_barrier(0);
#pragma unroll
                    for (int c = 0; c < 8; ++c) o[8 * half + c] = __builtin_amdgcn_mfma_f32_16x16x32_fp8_fp8(vt[c], bp, o[8 * half + c], 0, 0, 0);
                }
            }
#undef DSA_GATHER
            float l = l_run; l += __shfl_xor(l, 16); l += __shfl_xor(l, 32);
            const float inv = Y8_SCALE / l;
            if (l15 < NH) {
                unsigned char* orow = ((dummy || (DSA_PROBE == 3 && rp3 == 0)) ? ws + WS_H + (size_t)(tok & 8191) * QABS_W + l15 * KVL : ws + WS_R0 + R0_C + (size_t)tok * YW8 + l15 * KVL) + 4 * g4;
#pragma unroll
                for (int ct = 0; ct < 16; ++ct) *(unsigned*)(orow + 16 * ct) = cvt4_fp8(o[ct][0] * inv, o[ct][1] * inv, o[ct][2] * inv, o[ct][3] * inv);
            }
        }
    }
    __syncthreads();
}

__device__ __forceinline__ unsigned off_b(unsigned row, unsigned ch) { return 256u * row + 16u * (ch ^ (((row & 3u) << 2) | ((row >> 2) & 3u))); }
template <bool Y16>
__device__ __forceinline__ void phase_memattn(const Frame& F, int layer) {
    unsigned char* ws = F.ws;
    const bf16_t* qmem = (const bf16_t*)(ws + WS_QMEM);
    const bf16_t* mkv = (const bf16_t*)(ws + WS_MKV);
    unsigned char* ymix = ws + WS_R0 + R0_C;
    const int lane = F.lane, wave = F.wave, l15 = lane & 15, g4 = lane >> 4;
    LAS unsigned char* Kl = F.lds; LAS unsigned char* Vl = F.lds + 65536;
    const unsigned Vl_a = (unsigned)(size_t)Vl;
    int staged = -1;
    for (int unit = F.bx; unit < 512; unit += F.G) {
        const int combo = unit & 15, qb = unit >> 4, b = combo >> 2, head = combo & 3;
        if (combo != staged) {
            __syncthreads();
            const bf16_t* kb = mkv + (size_t)(b * NMEM) * 4096 + layer * 1024 + head * HD;
#pragma unroll
            for (int i = 0; i < 8; ++i) { const int idx = F.tid + 512 * i, row = idx >> 4, ch = idx & 15;
                const u32x4 kv = *(const u32x4*)(kb + (size_t)row * 4096 + 8 * ch), vv = *(const u32x4*)(kb + (size_t)row * 4096 + 512 + 8 * ch);
                *(LAS u32x4*)(Kl + off_b(row, ch)) = kv; *(LAS u32x4*)(Vl + off_b(row, ch)) = vv; }
            __syncthreads();
            staged = combo;
        }
        const int tok = b * T + qb * 128 + wave * 16 + l15;
        bf16x8 bq[4];
#pragma unroll
        for (int s = 0; s < 4; ++s) bq[s] = *(const bf16x8*)(qmem + (size_t)tok * MW + head * HD + 32 * s + 8 * g4);
        f32x4 st[16];
        {
            const unsigned Kl_a = (unsigned)(size_t)Kl, fxk = (((unsigned)l15 & 3u) << 2) | (((unsigned)l15 >> 2) & 3u);
            unsigned ka[4];
#pragma unroll
            for (int s = 0; s < 4; ++s) ka[s] = Kl_a + 256u * (unsigned)l15 + 16u * (((unsigned)(4 * s + g4)) ^ fxk);
#define MEM_K4(RB0) { bf16x8 kf[16]; _Pragma("unroll") for (int s = 0; s < 4; ++s) \
                asm volatile("ds_read_b128 %0, %4 offset:%c5\n\tds_read_b128 %1, %4 offset:%c6\n\tds_read_b128 %2, %4 offset:%c7\n\tds_read_b128 %3, %4 offset:%c8" \
                    : "=&v"(kf[s]), "=&v"(kf[4 + s]), "=&v"(kf[8 + s]), "=&v"(kf[12 + s]) : "v"(ka[s]), "i"(4096 * (RB0)), "i"(4096 * (RB0) + 4096), "i"(4096 * (RB0) + 8192), "i"(4096 * (RB0) + 12288) : "memory"); \
              asm volatile("s_waitcnt lgkmcnt(0)" ::: "memory"); __builtin_amdgcn_sched_barrier(0); \
              _Pragma("unroll") for (int r4 = 0; r4 < 4; ++r4) { st[(RB0) + r4] = (f32x4){0.f, 0.f, 0.f, 0.f}; \
                _Pragma("unroll") for (int s = 0; s < 4; ++s) st[(RB0) + r4] = __builtin_amdgcn_mfma_f32_16x16x32_bf16(kf[4 * r4 + s], bq[s], st[(RB0) + r4], 0, 0, 0); } }
            MEM_K4(0) MEM_K4(4) MEM_K4(8) MEM_K4(12)
#undef MEM_K4
        }
        float mx = -INFINITY;
#pragma unroll
        for (int rb = 0; rb < 16; ++rb)
#pragma unroll
            for (int r = 0; r < 4; ++r) mx = fmaxf(mx, st[rb][r]);
        mx = fmaxf(mx, __shfl_xor(mx, 16)); mx = fmaxf(mx, __shfl_xor(mx, 32));
        const float sc = 0.08838834764831845f; float ps = 0.f;
#pragma unroll
        for (int rb = 0; rb < 16; ++rb)
#pragma unroll
            for (int r = 0; r < 4; ++r) { st[rb][r] = __expf((st[rb][r] - mx) * sc); ps += st[rb][r]; }
        ps += __shfl_xor(ps, 16); ps += __shfl_xor(ps, 32);
        const float inv = (Y16 ? 1.0f : Y8_SCALE) / ps;
        bf16x8 bp[8];
#pragma unroll
        for (int ks = 0; ks < 8; ++ks) { u32x4 w; w.x = cvtpk(st[2 * ks][0], st[2 * ks][1]); w.y = cvtpk(st[2 * ks][2], st[2 * ks][3]); w.z = cvtpk(st[2 * ks + 1][0], st[2 * ks + 1][1]); w.w = cvtpk(st[2 * ks + 1][2], st[2 * ks + 1][3]);
            bp[ks] = __builtin_bit_cast(bf16x8, w); }
        const unsigned q4 = (unsigned)l15 >> 2, p4 = (unsigned)lane & 3u, fx = (q4 << 2) | (unsigned)g4;
        unsigned char* orow = Y16 ? ymix + ((size_t)tok * D + PW + head * HD + 4 * g4) * 2 : ymix + (size_t)tok * YW8 + QABS_W_ + head * HD + 4 * g4;
#pragma unroll
        for (int c = 0; c < 8; ++c) {
            f32x4 oc = (f32x4){0.f, 0.f, 0.f, 0.f};
            const unsigned a0 = Vl_a + 256u * (4u * g4 + q4) + 16u * ((2u * c + (p4 >> 1)) ^ fx) + 8u * (p4 & 1u);
            s16x4 vr[16];
#define MEM_TR4(KS) asm volatile("ds_read_b64_tr_b16 %0, %4 offset:%c5\n\tds_read_b64_tr_b16 %1, %4 offset:%c6\n\tds_read_b64_tr_b16 %2, %4 offset:%c7\n\tds_read_b64_tr_b16 %3, %4 offset:%c8" \
                : "=&v"(vr[2 * (KS)]), "=&v"(vr[2 * (KS) + 1]), "=&v"(vr[2 * (KS) + 2]), "=&v"(vr[2 * (KS) + 3]) : "v"(a0), "i"(8192 * (KS)), "i"(8192 * (KS) + 4096), "i"(8192 * (KS) + 8192), "i"(8192 * (KS) + 12288) : "memory");
            MEM_TR4(0) MEM_TR4(2) MEM_TR4(4) MEM_TR4(6)
#undef MEM_TR4
            asm volatile("s_waitcnt lgkmcnt(0)" ::: "memory"); __builtin_amdgcn_sched_barrier(0);
#pragma unroll
            for (int ks = 0; ks < 8; ++ks) { const bf16x8 af = __builtin_shufflevector(vr[2 * ks], vr[2 * ks + 1], 0, 1, 2, 3, 4, 5, 6, 7); oc = __builtin_amdgcn_mfma_f32_16x16x32_bf16(af, bp[ks], oc, 0, 0, 0); }
            if constexpr (Y16) { u32x2 o; o.x = cvtpk(oc[0] * inv, oc[1] * inv); o.y = cvtpk(oc[2] * inv, oc[3] * inv); *(u32x2*)(orow + 32 * c) = o; }
            else *(unsigned*)(orow + 16 * c) = cvt4_fp8(oc[0] * inv, oc[1] * inv, oc[2] * inv, oc[3] * inv);
        }
    }
    __syncthreads();
}

template <int W>
__device__ __forceinline__ void pool_item(const bf16_t* U, bf16_t* Y, int tok0, int t0, int c8) {
    constexpr int NR = W - 1 + 8;
    u32x4 rows[NR];
#pragma unroll
    for (int k = 0; k < NR; ++k) { const int dt = k - (W - 1); const bool ok = t0 + dt >= 0;
        const u32x4 v = *(const u32x4*)(U + (size_t)(tok0 + (ok ? dt : 0)) * PW + c8);
        rows[k] = (u32x4){ok ? v.x : 0u, ok ? v.y : 0u, ok ? v.z : 0u, ok ? v.w : 0u}; }
    float s[8];
#pragma unroll
    for (int e = 0; e < 8; ++e) s[e] = 0.f;
#pragma unroll
    for (int k = 0; k < W - 1; ++k) { const unsigned vv[4] = {rows[k].x, rows[k].y, rows[k].z, rows[k].w};
#pragma unroll
        for (int e = 0; e < 4; ++e) { s[2 * e] += __builtin_bit_cast(float, vv[e] << 16); s[2 * e + 1] += __builtin_bit_cast(float, vv[e] & 0xffff0000u); } }
#pragma unroll
    for (int ti = 0; ti < 8; ++ti) {
        const unsigned nw[4] = {rows[W - 1 + ti].x, rows[W - 1 + ti].y, rows[W - 1 + ti].z, rows[W - 1 + ti].w};
        float own[8];
#pragma unroll
        for (int e = 0; e < 4; ++e) { own[2 * e] = __builtin_bit_cast(float, nw[e] << 16); own[2 * e + 1] = __builtin_bit_cast(float, nw[e] & 0xffff0000u); s[2 * e] += own[2 * e]; s[2 * e + 1] += own[2 * e + 1]; }
        const int t = t0 + ti, n = (t + 1) < W ? (t + 1) : W; const float rn = 1.0f / (float)n;
        u32x4 o; o.x = cvtpk(s[0] * rn - own[0], s[1] * rn - own[1]); o.y = cvtpk(s[2] * rn - own[2], s[3] * rn - own[3]);
        o.z = cvtpk(s[4] * rn - own[4], s[5] * rn - own[5]); o.w = cvtpk(s[6] * rn - own[6], s[7] * rn - own[7]);
        *(u32x4*)(Y + (size_t)(tok0 + ti) * D + c8) = o;
        const unsigned od[4] = {rows[ti].x, rows[ti].y, rows[ti].z, rows[ti].w};
#pragma unroll
        for (int e = 0; e < 4; ++e) { s[2 * e] -= __builtin_bit_cast(float, od[e] << 16); s[2 * e + 1] -= __builtin_bit_cast(float, od[e] & 0xffff0000u); }
    }
}
__device__ __forceinline__ void phase_pool(const Frame& F) {
    unsigned char* ws = F.ws;
    const bf16_t* U = (const bf16_t*)(ws + WS_R0);
    bf16_t* Y = (bf16_t*)(ws + WS_R0 + R0_C);
    const int gw = F.bx * NWAVES + F.wave, NGW = F.G * NWAVES;
    for (int it = gw; it < (M / 8) * 4; it += NGW) {
        const int run = it >> 2, g = it & 3, tok0 = run * 8, t0 = tok0 % T;
        if (F.lane < PGW / 8) { const int c8 = g * PGW + 8 * F.lane;
            if (g == 0) pool_item<2>(U, Y, tok0, t0, c8); else if (g == 1) pool_item<4>(U, Y, tok0, t0, c8); else if (g == 2) pool_item<8>(U, Y, tok0, t0, c8); else pool_item<16>(U, Y, tok0, t0, c8); }
    }
}

__device__ __forceinline__ void final_norm_row(const bf16_t* xrow, const float* prow, const float* gain, float* orow, int lane) {
    u32x2 xw[8];
#pragma unroll
    for (int j = 0; j < 8; ++j) xw[j] = ((const u32x2*)xrow)[lane + 64 * j];
    float p = prow[lane & 31];
#pragma unroll
    for (int o = 1; o < 32; o <<= 1) p += __shfl_xor(p, o);
    const float rstd = 1.0f / sqrtf(p * (1.0f / D) + EPS);
#pragma unroll
    for (int j = 0; j < 8; ++j) { const f32x4 gv = ((const f32x4*)gain)[lane + 64 * j];
        const f32x4 v = (f32x4){__builtin_bit_cast(float, xw[j].x << 16), __builtin_bit_cast(float, xw[j].x & 0xffff0000u), __builtin_bit_cast(float, xw[j].y << 16), __builtin_bit_cast(float, xw[j].y & 0xffff0000u)};
        ((f32x4*)orow)[lane + 64 * j] = v * rstd * gv; }
}
__device__ __forceinline__ void phase_rstd(const Frame& F) {
    const float* part = (const float*)(F.ws + WS_PART); float* rstd = (float*)(F.ws + WS_RSTD);
    const int gw = F.bx * NWAVES + F.wave, NGW = F.G * NWAVES;
    for (int r2 = gw; r2 < M / 2; r2 += NGW) { const int row = 2 * r2 + (F.lane >> 5);
        float p = part[(size_t)row * 32 + (F.lane & 31)];
#pragma unroll
        for (int o = 1; o < 32; o <<= 1) p += __shfl_xor(p, o);
        if ((F.lane & 31) == 0) rstd[row] = 1.0f / sqrtf(p * (1.0f / D) + EPS); }
}

__device__ __forceinline__ void panel_rstd(const Frame& F, const pg8::StaticOrder& S0) {
    pg8::StaticOrder S = S0; asm volatile("" : "+s"(S.c), "+s"(S.G), "+s"(S.nN));
    int tl = F.tid; asm volatile("" : "+v"(tl));
    const float* part = (const float*)(F.ws + WS_PART); float* rstd = (float*)(F.ws + WS_RSTD);
    int last = -1; pg8::Unit u;
    for (int i = 0; S.next(i, u); ++i) if (u.pm != last) { last = u.pm;
        const int row = 256 * u.pm + (tl >> 1); const f32x4* pp = (const f32x4*)(part + (size_t)row * 32 + 16 * (tl & 1));
        const f32x4 a = pp[0], b = pp[1], c = pp[2], d = pp[3];
        float p = ((a.x + a.y) + (a.z + a.w)) + ((b.x + b.y) + (b.z + b.w)) + ((c.x + c.y) + (c.z + c.w)) + ((d.x + d.y) + (d.z + d.w));
        p += __shfl_xor(p, 1);
        if ((tl & 1) == 0) rstd[row] = 1.0f / sqrtf(p * (1.0f / D) + EPS); }
    VM_WAIT(); __syncthreads();
}

constexpr int PH_PER_LAYER = 10, N_PHASES = 1 + DEPTH * PH_PER_LAYER;

__global__ void __launch_bounds__(NWAVES * 64, 2) trunk_fwd(Args args) {
    extern __shared__ __attribute__((aligned(16))) unsigned char lds_raw[];
    LAS unsigned char* const lds = (LAS unsigned char*)lds_raw;
    volatile LAS unsigned* misc = (volatile LAS unsigned*)(lds + LDS_MISC_OFF);
    if (threadIdx.x < 16) misc[threadIdx.x] = 0u;
    const int wv0 = __builtin_amdgcn_readfirstlane((int)threadIdx.x >> 6);
    __syncthreads();
    unsigned* barw = (unsigned*)(args.ws + WS_CTL) + 4096 + (size_t)args.li * XCD_BAR_WORDS;
    XcdBarrier bar; bar.bar = barw; bar.x = 0; bar.st = misc; bar.wv = wv0;
    if ((args.ph_hi - args.ph_lo) > 1) bar = xcd_barrier_post(barw, misc, wv0);
    const int lo = args.ph_lo, hi = args.ph_hi;
#define IN(k) (lo <= (k) && (k) < hi)
#define SEAM(k) do { if (IN(k) && IN((k) + 1)) { XcdBarrier b2 = bar; asm volatile("" : "+s"(b2.bar), "+s"(b2.x)); xcd_barrier(b2); } } while (0)
#define SITE() const Frame F = make_frame(lds, wv0); unsigned char* const ws = F.ws; (void)ws

    _Pragma("unroll") for (int rep = 0; rep < NREP(0); ++rep) { if (IN(0)) { SITE(); phase_prologue(F); } }
    SEAM(0);

    for (int l = 0; l < DEPTH; ++l) {
        const int pb = 1 + l * PH_PER_LAYER, j = l >> 1;
        const bool dsa = (l & 1) == 0;
        if (dsa) {
            if (IN(pb + 0)) {
                _Pragma("unroll") for (int rep = 0; rep < NREP(1); ++rep) { SITE(); pg8::Gemm g{(const bf16_t*)(ws + WS_XRES), (const bf16_t*)(ws + WS_BT_INATTN) + (size_t)j * ATTN_IN_PAD * D, D, D, D, M / 256, ATTN_IN_PAD / 256, 1 << 20, 0};
                  pg8::StaticOrder S; S.init(g.nM, g.nN, F.G, F.bx); pg8::EpiF32 E{(float*)(ws + WS_R0), ATTN_IN_PAD, (const float*)(ws + WS_RSTD)};
                  if (l > 0) panel_rstd(F, S);
                  pg8::gemm_phase<pg8::EpiF32>(F.lds, F.tid, F.wave, g, S, E); }
                if (l == 0) _Pragma("unroll") for (int rep = 0; rep < NREP(2); ++rep) {
                    SITE(); pg8::Gemm g{(const bf16_t*)(ws + WS_MEMN), (const bf16_t*)(ws + WS_BT_MEMKV), D, D, D, 1024 / 256, 4096 / 256, 1 << 20, 0};
                    pg8::StaticOrder S; S.init(g.nM, g.nN, F.G, (F.bx + F.G / 2) % F.G); pg8::EpiSplit E{(bf16_t*)(ws + WS_MKV), 4096, (bf16_t*)(ws + WS_MKV), 4096, 1 << 20, 1.0f};
                    pg8::gemm_phase<pg8::EpiSplit>(F.lds, F.tid, F.wave, g, S, E); }
                if (l == 0) {
                    { SITE(); pg8::Gemm g{(const bf16_t*)(ws + WS_BT_OUTT), (const bf16_t*)(ws + WS_BT_GROUP), 2 * PW, PGW, PGW, D / 256, 2 * 2048 / 256, 2, PGW};
                        const int q = F.G / 4, cf = F.bx >= F.G - q ? F.bx - (F.G - q) : (1 << 20);
                        pg8::StaticOrder S; S.init(g.nM, g.nN, q, cf); pg8::EpiGroup E{(bf16_t*)(ws + WS_BT_OUT + SZ_BT_OUT), D, (int)(SZ_BT_OUT) - PW};
                        pg8::gemm_phase<pg8::EpiGroup>(F.lds, F.tid, F.wave, g, S, E); }
                    { SITE(); pg8::Gemm g{(const bf16_t*)(ws + WS_BT_OUTTD), (const bf16_t*)(ws + WS_BT_UV), 2 * PW, HD, HD, D / 256, 2 * NH, 1, HD};
                        const int q = F.G / 4, cf = F.bx >= F.G - q ? F.bx - (F.G - q) : (1 << 20);
                        pg8::StaticOrder S; S.init(g.nM, g.nN, q, cf); pg8::EpiFp8 E{ws + WS_BT_OUT, YW8, W8_SCALE, NH, (int)(2 * SZ_BT_OUT) - QABS_W_};
                        pg8::gemm_phase<pg8::EpiFp8>(F.lds, F.tid, F.wave, g, S, E); }
                }
            }
            SEAM(pb + 0);
            if (IN(pb + 1)) _Pragma("unroll") for (int rep = 0; rep < NREP(3); ++rep) { SITE(); phase_postproj(F, F.in(12) + j * QL, F.in(13) + j * KVL, F.in(18) + j * IDM, F.in(19) + j * IDM); }
            SEAM(pb + 1);
            if (IN(pb + 2)) _Pragma("unroll") for (int rep = 0; rep < NREP(4); ++rep) {
                SITE(); pg8::Gemm g{(const bf16_t*)(ws + WS_CQN), (const bf16_t*)(ws + WS_BT_Q) + (size_t)j * NQ * QL, QL, QL, QL, M / 256, NQ / 256, 1 << 20, 0};
                pg8::StaticOrder S; S.init(g.nM, g.nN, F.G, F.bx); pg8::EpiSplit E{(bf16_t*)(ws + WS_R0), QABS_W, (bf16_t*)(ws + WS_R0 + R0_B), 1024, QABS_W / 256, 1.0f};
                pg8::gemm_phase<pg8::EpiSplit>(F.lds, F.tid, F.wave, g, S, E);
            }
            SEAM(pb + 2);
            if (IN(pb + 3)) { _Pragma("unroll") for (int rep = 0; rep < NREP(5); ++rep) { SITE(); phase_dsa(F, rep + 1 < NREP(5)); } _Pragma("unroll") for (int rep = 0; rep < NREP(6); ++rep) { SITE(); phase_memattn<false>(F, l); } }
            SEAM(pb + 3);
        } else {
            if (IN(pb + 0)) _Pragma("unroll") for (int rep = 0; rep < NREP(8); ++rep) {
                SITE(); pg8::Gemm g{(const bf16_t*)(ws + WS_XRES), (const bf16_t*)(ws + WS_BT_INPOOL) + (size_t)j * D * D, D, D, D, M / 256, D / 256, 1 << 20, 0};
                pg8::StaticOrder S; S.init(g.nM, g.nN, F.G, F.bx); pg8::EpiSplitRS E{(bf16_t*)(ws + WS_R0), PW, (bf16_t*)(ws + WS_QMEM), MW, PW / 256, (const float*)(ws + WS_RSTD)};
                panel_rstd(F, S);
                pg8::gemm_phase<pg8::EpiSplitRS>(F.lds, F.tid, F.wave, g, S, E);
            }
            SEAM(pb + 0);
            if (IN(pb + 3)) { _Pragma("unroll") for (int rep = 0; rep < NREP(9); ++rep) { SITE(); phase_pool(F); } _Pragma("unroll") for (int rep = 0; rep < NREP(6); ++rep) { SITE(); phase_memattn<true>(F, l); } }
            SEAM(pb + 3);
        }
        if (IN(pb + 5)) _Pragma("unroll") for (int rep = 0; rep < NREP(11); ++rep) {
            if (dsa) { SITE(); pg8::Gemm g{(const bf16_t*)(ws + WS_R0 + R0_C), (const bf16_t*)(ws + WS_BT_OUT + (size_t)l * SZ_BT_OUT), YW8 / 2, YW8 / 2, YW8 / 2, M / 256, D / 256, 1 << 20, 0};
                pg8::StaticOrder S; S.init(g.nM, g.nN, F.G, F.bx); pg8::EpiResid<true> E{(bf16_t*)(ws + WS_XRES), ws + WS_H, (float*)(ws + WS_PART), 1.0f / (W8_SCALE * Y8_SCALE)};
                pg8::gemm_phase<pg8::EpiResid<true>, true>(F.lds, F.tid, F.wave, g, S, E); }
            else { SITE(); pg8::Gemm g{(const bf16_t*)(ws + WS_R0 + R0_C), (const bf16_t*)(ws + WS_BT_OUT + (size_t)l * SZ_BT_OUT), D, D, D, M / 256, D / 256, 1 << 20, 0};
                pg8::StaticOrder S; S.init(g.nM, g.nN, F.G, F.bx); pg8::EpiResid<true> E{(bf16_t*)(ws + WS_XRES), ws + WS_H, (float*)(ws + WS_PART), 1.0f};
                pg8::gemm_phase<pg8::EpiResid<true>>(F.lds, F.tid, F.wave, g, S, E); }
        }
        SEAM(pb + 5);
        if (IN(pb + 7)) _Pragma("unroll") for (int rep = 0; rep < NREP(13); ++rep) {
            SITE(); pg8::Gemm g{(const bf16_t*)(ws + WS_H), (const bf16_t*)(ws + WS_BT_GU + (size_t)l * SZ_BT_GU), D / 2, D / 2, D / 2, M / 256, 2 * DFF / 256, 1 << 20, 0};
            pg8::StaticOrder S; S.init(g.nM, g.nN, F.G, F.bx); pg8::EpiSwiGLU E{ws + WS_R0, DFF, 1.0f / W8_SCALE, (const float*)(ws + WS_RSTD)};
            panel_rstd(F, S);
            pg8::gemm_phase<pg8::EpiSwiGLU, true>(F.lds, F.tid, F.wave, g, S, E);
        }
        SEAM(pb + 7);
        if (IN(pb + 8)) _Pragma("unroll") for (int rep = 0; rep < NREP(14); ++rep) {
            SITE(); pg8::Gemm g{(const bf16_t*)(ws + WS_R0), (const bf16_t*)(ws + WS_BT_DOWN + (size_t)l * D * DFF), DFF / 2, DFF / 2, DFF / 2, M / 256, D / 256, 1 << 20, 0};
            pg8::StaticOrder S; S.init(g.nM, g.nN, F.G, F.bx);
            pg8::EpiResid<false> E{(bf16_t*)(ws + WS_XRES), nullptr, (float*)(ws + WS_PART), 1.0f / (W8_SCALE * GU8_SCALE)}; pg8::gemm_phase<pg8::EpiResid<false>, true>(F.lds, F.tid, F.wave, g, S, E);
        }
        SEAM(pb + 8);
        if (IN(pb + 9) && l + 1 == DEPTH) { SITE();
            const int gw = F.bx * NWAVES + F.wave, NGW = F.G * NWAVES; const bf16_t* xres = (const bf16_t*)(ws + WS_XRES); const float* part = (const float*)(ws + WS_PART); const float* gn = F.in(4); float* outp = F.out();
            for (int m = gw; m < M; m += NGW) final_norm_row(xres + (size_t)m * D, part + (size_t)m * 32, gn, outp + (size_t)m * D, F.lane); }
    }
#undef IN
#undef SEAM
#undef SITE
}

extern "C" void kernel_launch(void* const* d_in, const int* in_sizes, int n_in, void* d_out, int out_size, void* d_ws, size_t ws_size, hipStream_t stream) {
    static int grid = 0;
    if (grid == 0) {
        if (n_in != 23 || in_sizes[0] != M * D || out_size != M * D || ws_size < WS_END) {
            fprintf(stderr, "kernel_launch: unexpected shapes (n_in %d, in0 %d, out %d, ws %zu, need %zu); nothing launched\n", n_in, n_in > 0 ? in_sizes[0] : -1, out_size, ws_size, (size_t)WS_END); grid = -1; return; }
        int dev = 0, cus = 0, per_cu = 0;
        if (hipGetDevice(&dev) != hipSuccess || hipDeviceGetAttribute(&cus, hipDeviceAttributeMultiprocessorCount, dev) != hipSuccess) { grid = -1; return; }
        if (hipFuncSetAttribute((const void*)trunk_fwd, hipFuncAttributeMaxDynamicSharedMemorySize, LDS_BYTES) != hipSuccess) { fprintf(stderr, "kernel_launch: hipFuncSetAttribute failed\n"); grid = -1; return; }
        if (hipOccupancyMaxActiveBlocksPerMultiprocessor(&per_cu, (const void*)trunk_fwd, NWAVES * 64, LDS_BYTES) != hipSuccess || per_cu < 1) {
            fprintf(stderr, "kernel_launch: occupancy query reports %d workgroups per CU\n", per_cu); (void)hipGetLastError(); grid = -1; return; }
        grid = cus;
    }
    if (grid < 0) return;
    if (hipMemsetAsync((char*)d_ws + WS_CTL, 0, CTL_BYTES, stream) != hipSuccess) return;
    Args a{};
    for (int i = 0; i < 23; ++i) a.in[i] = (const float*)d_in[i];
    a.out = (float*)d_out; a.ws = (unsigned char*)d_ws;
#if MK_N_LAUNCHES == 1
    a.ph_lo = 0; a.ph_hi = N_PHASES; a.li = 0;
    hipLaunchKernelGGL(trunk_fwd, dim3(grid), dim3(NWAVES * 64), LDS_BYTES, stream, a);
#else
    for (int p = 0; p < N_PHASES; ++p) {
        if (p >= 1) { const int l = (p - 1) / PH_PER_LAYER, k = (p - 1) % PH_PER_LAYER; if (k == 4 || ((l & 1) == 1 && (k == 1 || k == 2))) continue; }
        a.ph_lo = p; a.ph_hi = p + 1; a.li = 0;
        hipLaunchKernelGGL(trunk_fwd, dim3(grid), dim3(NWAVES * 64), LDS_BYTES, stream, a);
    }
#endif
}
```

```cpp
#include <hip/hip_runtime.h>
#include <cstdio>
#include <cstdint>

#ifndef MK_N_LAUNCHES
#define MK_N_LAUNCHES 1
#endif

#ifndef PROBE_MASK
#define PROBE_MASK 0u
#endif
#define NREP(k) (1 + (int)((PROBE_MASK >> (k)) & 1u))
#ifndef DSA_PROBE
#define DSA_PROBE 0
#endif
#define LAS __attribute__((address_space(3)))
#define GAS __attribute__((address_space(1)))
typedef unsigned short bf16_t;
typedef short bf16x8 __attribute__((ext_vector_type(8)));
typedef short s16x4 __attribute__((ext_vector_type(4)));
typedef float f32x4 __attribute__((ext_vector_type(4)));
typedef float f32x2 __attribute__((ext_vector_type(2)));
typedef float f32x16 __attribute__((ext_vector_type(16)));
typedef unsigned u32x4 __attribute__((ext_vector_type(4)));
typedef unsigned u32x2 __attribute__((ext_vector_type(2)));
typedef __bf16 hbf16x2 __attribute__((ext_vector_type(2)));
typedef int i32x4 __attribute__((ext_vector_type(4)));
typedef int i32x8 __attribute__((ext_vector_type(8)));

constexpr int D = 2048, NB = 4, T = 4096, M = NB * T, DEPTH = 4;
constexpr int HD = 128, NH = 12, QL = 512, KVL = 256, IH = 16, IDM = 64, TOPK = 256;
constexpr int QABS_W_ = 12 * 256;
constexpr int NMEM = 256, MH = 4, MW = 512, DFF = 5632, ATTN_IN = 1360, PW = 1536, PGW = 384;
constexpr int YW8 = QABS_W_ + MW  , ATTN_IN_PAD = 1536, NQ = 4096  , QABS_W = NH * KVL  ;
constexpr float EPS = 1e-6f;

constexpr size_t al256(size_t x) { return (x + 255) & ~(size_t)255; }
constexpr size_t WS_CTL = 0, CTL_BYTES = 1u << 20;
constexpr size_t SZ_BT_GU = (size_t)2 * DFF * D  , SZ_BT_DOWN = (size_t)D * DFF  , SZ_BT_OUT = (size_t)D * D * 2;
constexpr size_t SZ_BT_INATTN = (size_t)ATTN_IN_PAD * D * 2, SZ_BT_Q = (size_t)NQ * QL * 2, SZ_BT_UV = (size_t)1536 * 512 * 2;
constexpr size_t SZ_BT_INPOOL = (size_t)D * D * 2, SZ_BT_GROUP = (size_t)2048 * PGW * 2, SZ_BT_MEMKV = (size_t)4096 * D * 2, SZ_BT_OUTT = (size_t)D * PW * 2;
constexpr size_t WS_BT_GU = WS_CTL + CTL_BYTES;
constexpr size_t WS_BT_DOWN = WS_BT_GU + 4 * SZ_BT_GU;
constexpr size_t WS_BT_OUT = WS_BT_DOWN + 4 * SZ_BT_DOWN;
constexpr size_t WS_BT_INATTN = WS_BT_OUT + 4 * SZ_BT_OUT;
constexpr size_t WS_BT_Q = WS_BT_INATTN + 2 * SZ_BT_INATTN;
constexpr size_t WS_BT_UV = WS_BT_Q + 2 * SZ_BT_Q;
constexpr size_t WS_BT_INPOOL = WS_BT_UV + 2 * SZ_BT_UV;
constexpr size_t WS_BT_GROUP = WS_BT_INPOOL + 2 * SZ_BT_INPOOL;
constexpr size_t WS_BT_OUTT = WS_BT_GROUP + 2 * SZ_BT_GROUP;
constexpr size_t WS_BT_OUTTD = WS_BT_OUTT + 2 * SZ_BT_OUTT;
constexpr size_t WS_BT_MEMKV = WS_BT_OUTTD + 2 * SZ_BT_OUTT;
constexpr size_t WS_MEMN = WS_BT_MEMKV + SZ_BT_MEMKV;
constexpr size_t WS_MKV = WS_MEMN + (size_t)1024 * D * 2;
constexpr size_t WS_XRES = WS_MKV + (size_t)1024 * 4096 * 2;
constexpr size_t WS_H = WS_XRES + (size_t)M * D * 4;
constexpr size_t WS_R0 = WS_H + (size_t)M * D * 2;
constexpr size_t R0_B = (size_t)M * 1536 * 4, R0_C = R0_B + (size_t)M * 1536 * 2;
constexpr size_t SZ_R0 = R0_C + (size_t)M * D * 2;
static_assert((size_t)M * DFF * 2 <= SZ_R0 && (size_t)M * QABS_W * 2 <= R0_B && (size_t)M * 1024 * 2 <= R0_C - R0_B, "arena");
constexpr size_t WS_CQN = WS_R0 + SZ_R0;
constexpr size_t WS_CKV = WS_CQN + (size_t)M * QL * 2;
constexpr size_t WS_KIDX = WS_CKV + (size_t)M * KVL * 2;
constexpr size_t WS_WIDX = WS_KIDX + (size_t)M * IDM * 2;
constexpr size_t WS_RSTD = WS_WIDX + (size_t)M * IH * 4;
constexpr size_t WS_PART = WS_RSTD + (size_t)M * 4;
constexpr size_t WS_PARTQ = WS_PART + (size_t)M * 32 * 4;
constexpr size_t WS_RSTDQ = WS_PARTQ + (size_t)M * 8 * 4;
constexpr size_t WS_CQ8 = WS_RSTDQ + (size_t)M * 4;
constexpr size_t WS_BT_QA8 = WS_CQ8 + (size_t)M * QL;
constexpr size_t WS_QMEM = WS_BT_QA8 + (size_t)2 * QABS_W_ * QL;
constexpr size_t WS_OLAT = WS_QMEM + (size_t)M * MW * 2;
constexpr size_t WS_END = WS_OLAT + (size_t)M * QABS_W * 2;

constexpr int RING_BYTES = 131072;
constexpr int LDS_IDX_OFF = RING_BYTES, IDX_STRIDE = 384;
constexpr int LDS_MISC_OFF = RING_BYTES + 6144;
constexpr int LDS_BYTES = 147456;
constexpr int NWAVES = 8;

__device__ __forceinline__ unsigned cvtpk(float lo, float hi) { f32x2 v = {lo, hi}; hbf16x2 b = __builtin_convertvector(v, hbf16x2); return __builtin_bit_cast(unsigned, b); }
__device__ __forceinline__ unsigned cvt4_fp8(float a, float b, float c, float d) { int w = 0; w = __builtin_amdgcn_cvt_pk_fp8_f32(a, b, w, false); w = __builtin_amdgcn_cvt_pk_fp8_f32(c, d, w, true); return (unsigned)w; }
constexpr float QA8_SCALE = 16.0f;
constexpr float Y8_SCALE = 16.0f;
constexpr float GU8_SCALE = 8.0f;
constexpr float QW8_SCALE = 256.0f;
constexpr float W8_SCALE = 64.0f;
__device__ __forceinline__ float bf2f(unsigned short h) { return __builtin_bit_cast(float, (unsigned)h << 16); }
__device__ __forceinline__ float wave_sum(float v) {
#pragma unroll
    for (int o = 1; o < 64; o <<= 1) v += __shfl_xor(v, o);
    return v;
}
__device__ __forceinline__ int wave_isum(int v) {
#pragma unroll
    for (int o = 1; o < 64; o <<= 1) v += __shfl_xor(v, o);
    return __builtin_amdgcn_readfirstlane(v);
}
#define VM_WAIT() asm volatile("s_waitcnt vmcnt(0)" ::: "memory")
#define LGKM_WAIT() asm volatile("s_waitcnt lgkmcnt(0)" ::: "memory")

#define XB_TMO      128
#define XB_XCNT(j)  (256  + 64 * (j))
#define XB_XSUB(j)  (1280 + 64 * (j))
#define XB_XGEN(j)  (2304 + 64 * (j))
#define XB_TOP      3328
#define XB_TOPGEN   3392
#define XCD_BAR_WORDS 3456
#define XB_SPIN_CAP (1u << 22)

__device__ __forceinline__ unsigned xb_ld(unsigned* p)              { return __hip_atomic_load(p, __ATOMIC_RELAXED, __HIP_MEMORY_SCOPE_AGENT); }
__device__ __forceinline__ unsigned xb_add(unsigned* p, unsigned v) { return __hip_atomic_fetch_add(p, v, __ATOMIC_RELAXED, __HIP_MEMORY_SCOPE_AGENT); }
__device__ __forceinline__ unsigned xb_xcc_id() { return (unsigned)__builtin_amdgcn_s_getreg((3 << 11) | 20) & 0xFu; }
#define XB_SPIN(cond, bar) do { unsigned _sp = 0; while (cond) { __builtin_amdgcn_s_sleep(1); \
    if ((++_sp & 255u) == 0u) { if (xb_ld(&(bar)[XB_TMO])) break; if (_sp > XB_SPIN_CAP) { atomicAdd(&(bar)[XB_TMO], 1u); break; } } } } while (0)

__device__ __forceinline__ int lane_now() { int ln; asm volatile("v_mbcnt_lo_u32_b32 %0, -1, 0\n\tv_mbcnt_hi_u32_b32 %0, -1, %0" : "=v"(ln)); return ln; }
struct XcdBarrier { unsigned* bar; unsigned x; volatile LAS unsigned* st; int wv; };

__device__ __forceinline__ XcdBarrier xcd_barrier_post(unsigned* bar, volatile LAS unsigned* st, int wv) {
    XcdBarrier b; b.bar = bar; b.x = xb_xcc_id(); b.st = st; b.wv = wv;
    if (wv == 0 && lane_now() == 0) (void)xb_add(&bar[XB_XCNT(b.x)], 1u);
    return b;
}
__device__ __forceinline__ void xcd_barrier_complete(unsigned* bar, unsigned x, unsigned& nloc, unsigned& nx) {
    const unsigned G = gridDim.x * gridDim.y * gridDim.z;
    unsigned sum, cnt, mine, sp = 0u;
    for (;;) {
        sum = 0u; cnt = 0u; mine = 0u;
#pragma unroll
        for (unsigned j = 0; j < 16; ++j) { const unsigned c = xb_ld(&bar[XB_XCNT(j)]); sum += c; cnt += (c > 0u) ? 1u : 0u; mine = (j == x) ? c : mine; }
        if (sum == G) break;
        __builtin_amdgcn_s_sleep(1);
        if ((++sp & 255u) == 0u) { if (xb_ld(&bar[XB_TMO])) break; if (sp > XB_SPIN_CAP) { atomicAdd(&bar[XB_TMO], 1u); break; } }
    }
    nloc = mine > 0u ? mine : 1u; nx = cnt > 0u ? cnt : 1u;
}
__device__ __forceinline__ void xcd_barrier(const XcdBarrier& b) {
    asm volatile("s_waitcnt vmcnt(0)" ::: "memory");
    __syncthreads();
    if (b.wv == 0 && lane_now() == 0) {
        unsigned* bar = b.bar;
        __builtin_amdgcn_s_waitcnt(0);
        unsigned nloc = b.st[0], nx = b.st[1];
        if (nloc == 0u) { xcd_barrier_complete(bar, b.x, nloc, nx); b.st[0] = nloc; b.st[1] = nx; }
        const unsigned old = xb_add(&bar[XB_XSUB(b.x)], 1u);
        const unsigned gen = old / nloc;
        if (old + 1u == (gen + 1u) * nloc) {
            __builtin_amdgcn_fence(__ATOMIC_RELEASE, "agent");
            asm volatile("s_waitcnt vmcnt(0)" ::: "memory");
            const unsigned og = xb_add(&bar[XB_TOP], 1u);
            const unsigned tg = og / nx;
            if (og + 1u == (tg + 1u) * nx) xb_add(&bar[XB_TOPGEN], 1u);
            else XB_SPIN(xb_ld(&bar[XB_TOPGEN]) == tg, bar);
            __builtin_amdgcn_fence(__ATOMIC_ACQUIRE, "agent");
            xb_add(&bar[XB_XGEN(b.x)], 1u);
            asm volatile("s_waitcnt vmcnt(0)" ::: "memory");
        } else {
            XB_SPIN(xb_ld(&bar[XB_XGEN(b.x)]) == gen, bar);
            __builtin_amdgcn_fence(__ATOMIC_ACQUIRE, "agent");
            asm volatile("s_waitcnt vmcnt(0)" ::: "memory");
        }
    }
    __syncthreads();
}

namespace pg8 {
constexpr int BM = 256, BK = 64, HALF = 128, HTB = HALF * BK * 2, STAGE_BYTES = 8 * HTB, NXCD = 8, WGM = 8;
__host__ __device__ __forceinline__ int lds_byte(int r, int c) { const int st = (r >> 4) * 2 + (c >> 5), rr = r & 15, cc = c & 31, ob = rr * 64 + cc * 2; return st * 1024 + (ob ^ (((ob >> 9) & 1) << 5)); }
__host__ __device__ __forceinline__ void stage_rc(int b, int& R, int& C) { const int st = b / 1024, sb = b % 1024, swz = sb ^ (((sb >> 9) & 1) << 5); R = (st >> 1) * 16 + swz / 64; C = (st & 1) * 32 + (swz % 64) / 2; }
__host__ __device__ __forceinline__ int perm32(int rho) { const int n = rho >> 4, i = rho & 15; return 8 * (i >> 2) + 4 * n + (i & 3); }

struct Unit { int pm, pn; };
struct Gemm { const bf16_t* A; const bf16_t* Bt; int lda, ldb, K, nM, nN, a_div, a_koff; };

struct StaticOrder {
    int nM, nN, nwg, G, c;
    __device__ void init(int nM_, int nN_, int G_, int c_) { nM = nM_; nN = nN_; nwg = nM * nN; G = G_; c = c_; }
    __device__ bool next(int i, Unit& u) const {
        const long L = (long)i * G + c; if (L >= nwg) return false;
        int wgid = (int)L; { const int q = nwg / NXCD, r = nwg % NXCD, xcd = wgid % NXCD, off = wgid / NXCD; wgid = (xcd < r ? xcd * (q + 1) : r * (q + 1) + (xcd - r) * q) + off; }
        const int nig = WGM * nN, gid = wgid / nig, fm = gid * WGM, gsz = (nM - fm) < WGM ? (nM - fm) : WGM;
        u.pm = fm + ((wgid % nig) % gsz); u.pn = (wgid % nig) / gsz; return true;
    }
};

struct EpiF32 {
    static constexpr bool PERM = false;
    float* C; int ldc; const float* rs;
    __device__ __forceinline__ void operator()(const f32x4 (&acc)[2][2][4][2], const Unit& u, int wr, int wc, int fr, int fq) const {
        const int row0 = u.pm * BM + wr * 64 + fr, col0 = u.pn * BM + wc * 32 + 4 * fq;
#pragma unroll
        for (int ai = 0; ai < 2; ++ai)
#pragma unroll
            for (int m = 0; m < 4; ++m) { float* rowp = C + (size_t)(row0 + ai * HALF + m * 16) * ldc + col0; const float r = rs[row0 + ai * HALF + m * 16];
#pragma unroll
                for (int bj = 0; bj < 2; ++bj)
#pragma unroll
                    for (int n = 0; n < 2; ++n) *(f32x4*)(rowp + bj * HALF + n * 16) = acc[ai][bj][m][n] * r; }
    }
};
struct EpiInAttn {
    static constexpr bool PERM = false;
    float* C; int ldc; const float* rs; bf16_t* CQ; float* partq; unsigned char* CQ8; bf16_t* QM;
    __device__ __forceinline__ void operator()(const f32x4 (&acc)[2][2][4][2], const Unit& u, int wr, int wc, int, int) const {
        const int ln = lane_now(), fr = ln & 15, fq = ln >> 4;
        const int row0 = u.pm * BM + wr * 64 + fr, col0 = u.pn * BM + wc * 32 + 4 * fq;
        if (u.pn < 2) {
#pragma unroll
            for (int ai = 0; ai < 2; ++ai)
#pragma unroll
                for (int m = 0; m < 4; ++m) { const int row = row0 + ai * HALF + m * 16; const float r = rs[row]; float ss = 0.f;
#pragma unroll
                    for (int bj = 0; bj < 2; ++bj)
#pragma unroll
                        for (int n = 0; n < 2; ++n) { const f32x4 v = acc[ai][bj][m][n] * r; ss += (v[0] * v[0] + v[1] * v[1]) + (v[2] * v[2] + v[3] * v[3]);
                            u32x2 w; w.x = cvtpk(v[0], v[1]); w.y = cvtpk(v[2], v[3]); *(u32x2*)(CQ + (size_t)row * QL + col0 + bj * HALF + n * 16) = w;
                            *(unsigned*)(CQ8 + (size_t)row * QL + col0 + bj * HALF + n * 16) = cvt4_fp8(v[0], v[1], v[2], v[3]); }
                    ss += __shfl_xor(ss, 16); ss += __shfl_xor(ss, 32);
                    if (fq == 0) partq[(size_t)row * 8 + 4 * u.pn + wc] = ss; }
        } else if (u.pn >= 4) {
            const int qc0 = 176 + (u.pn - 4) * BM + wc * 32 + 4 * fq;
#pragma unroll
            for (int ai = 0; ai < 2; ++ai)
#pragma unroll
                for (int m = 0; m < 4; ++m) { const int row = row0 + ai * HALF + m * 16; const float r = rs[row];
#pragma unroll
                    for (int bj = 0; bj < 2; ++bj)
#pragma unroll
                        for (int n = 0; n < 2; ++n) { const int qc = qc0 + bj * HALF + n * 16; const f32x4 v = acc[ai][bj][m][n] * r;
                            u32x2 w; w.x = cvtpk(v[0], v[1]); w.y = cvtpk(v[2], v[3]); if (qc < MW) *(u32x2*)(QM + (size_t)row * MW + qc) = w; } }
        } else {
#pragma unroll
            for (int ai = 0; ai < 2; ++ai)
#pragma unroll
                for (int m = 0; m < 4; ++m) { float* rowp = C + (size_t)(row0 + ai * HALF + m * 16) * ldc + col0; const float r = rs[row0 + ai * HALF + m * 16];
#pragma unroll
                    for (int bj = 0; bj < 2; ++bj)
#pragma unroll
                        for (int n = 0; n < 2; ++n) *(f32x4*)(rowp + bj * HALF + n * 16) = acc[ai][bj][m][n] * r; }
        }
    }
};
struct EpiSplit {
    static constexpr bool PERM = true;
    bf16_t* O0; int ld0; bf16_t* O1; int ld1; int split; float osc;
    __device__ __forceinline__ void operator()(const f32x4 (&acc)[2][2][4][2], const Unit& u, int wr, int wc, int fr, int fq) const {
        const int row0 = u.pm * BM + wr * 64 + fr;
        bf16_t* base; int ld, colt;
        if (u.pn < split) { base = O0; ld = ld0; colt = u.pn * BM; } else { base = O1; ld = ld1; colt = (u.pn - split) * BM; }
        const int col0 = colt + wc * 32 + 8 * fq;
#pragma unroll
        for (int ai = 0; ai < 2; ++ai)
#pragma unroll
            for (int m = 0; m < 4; ++m) { bf16_t* rowp = base + (size_t)(row0 + ai * HALF + m * 16) * ld + col0;
#pragma unroll
                for (int bj = 0; bj < 2; ++bj) { const f32x4 v0 = acc[ai][bj][m][0] * osc, v1 = acc[ai][bj][m][1] * osc;
                    u32x4 w; w.x = cvtpk(v0[0], v0[1]); w.y = cvtpk(v0[2], v0[3]); w.z = cvtpk(v1[0], v1[1]); w.w = cvtpk(v1[2], v1[3]);
                    *(u32x4*)(rowp + bj * HALF) = w; } }
    }
};
template <bool W8>
struct EpiResid {
    static constexpr bool PERM = true;
    bf16_t* X; unsigned char* X8; float* part; float osc;
    __device__ __forceinline__ void operator()(const f32x4 (&acc)[2][2][4][2], const Unit& u, int wr, int wc, int, int) const {
        const int ln = lane_now(), fr = ln & 15, fq = ln >> 4;
        const int row0 = u.pm * BM + wr * 64 + fr, col0 = u.pn * BM + wc * 32 + 8 * fq;
#pragma unroll
        for (int ai = 0; ai < 2; ++ai) {
            u32x4 xv[4][2];
#pragma unroll
            for (int m = 0; m < 4; ++m)
#pragma unroll
                for (int bj = 0; bj < 2; ++bj) xv[m][bj] = *(const u32x4*)(X + (size_t)(row0 + ai * HALF + m * 16) * D + col0 + bj * HALF);
#pragma unroll
            for (int m = 0; m < 4; ++m) { const int row = row0 + ai * HALF + m * 16; float ss = 0.f;
#pragma unroll
                for (int bj = 0; bj < 2; ++bj) { const unsigned xw[4] = {xv[m][bj].x, xv[m][bj].y, xv[m][bj].z, xv[m][bj].w}; float v[8];
#pragma unroll
                    for (int e = 0; e < 4; ++e) { v[2 * e] = __builtin_bit_cast(float, xw[e] << 16) + acc[ai][bj][m][e >> 1][2 * (e & 1)] * osc; v[2 * e + 1] = __builtin_bit_cast(float, xw[e] & 0xffff0000u) + acc[ai][bj][m][e >> 1][2 * (e & 1) + 1] * osc; }
#pragma unroll
                    for (int e = 0; e < 8; ++e) ss += v[e] * v[e];
                    u32x4 w; w.x = cvtpk(v[0], v[1]); w.y = cvtpk(v[2], v[3]); w.z = cvtpk(v[4], v[5]); w.w = cvtpk(v[6], v[7]);
                    *(u32x4*)(X + (size_t)row * D + col0 + bj * HALF) = w;
                    if constexpr (W8) { u32x2 w8; w8.x = cvt4_fp8(v[0], v[1], v[2], v[3]); w8.y = cvt4_fp8(v[4], v[5], v[6], v[7]); *(u32x2*)(X8 + (size_t)row * D + col0 + bj * HALF) = w8; } }
                ss += __shfl_xor(ss, 16); ss += __shfl_xor(ss, 32);
                if (fq == 0) part[(size_t)row * 32 + 4 * u.pn + wc] = ss; }
        }
    }
};
struct EpiSplitRS {
    static constexpr bool PERM = true;
    bf16_t* O0; int ld0; bf16_t* O1; int ld1; int split; const float* rs; float osc;
    __device__ __forceinline__ void operator()(const f32x4 (&acc)[2][2][4][2], const Unit& u, int wr, int wc, int, int) const {
        const int ln = lane_now(), fr = ln & 15, fq = ln >> 4;
        const int row0 = u.pm * BM + wr * 64 + fr;
        bf16_t* base; int ld, colt;
        if (u.pn < split) { base = O0; ld = ld0; colt = u.pn * BM; } else { base = O1; ld = ld1; colt = (u.pn - split) * BM; }
        const int col0 = colt + wc * 32 + 8 * fq;
#pragma unroll
        for (int ai = 0; ai < 2; ++ai)
#pragma unroll
            for (int m = 0; m < 4; ++m) { const int row = row0 + ai * HALF + m * 16; bf16_t* rowp = base + (size_t)row * ld + col0; const float r = rs[row] * osc;
#pragma unroll
                for (int bj = 0; bj < 2; ++bj) { const f32x4 v0 = acc[ai][bj][m][0] * r, v1 = acc[ai][bj][m][1] * r;
                    u32x4 w; w.x = cvtpk(v0[0], v0[1]); w.y = cvtpk(v0[2], v0[3]); w.z = cvtpk(v1[0], v1[1]); w.w = cvtpk(v1[2], v1[3]);
                    *(u32x4*)(rowp + bj * HALF) = w; } }
    }
};
struct EpiFp8RS {
    static constexpr bool PERM = true;
    unsigned char* O; int ldc; const float* rs; float osc;
    __device__ __forceinline__ void operator()(const f32x4 (&acc)[2][2][4][2], const Unit& u, int wr, int wc, int, int) const {
        const int ln = lane_now(), fr = ln & 15, fq = ln >> 4;
        const int row0 = u.pm * BM + wr * 64 + fr, col0 = u.pn * BM + wc * 32 + 8 * fq;
#pragma unroll
        for (int ai = 0; ai < 2; ++ai)
#pragma unroll
            for (int m = 0; m < 4; ++m) { const int row = row0 + ai * HALF + m * 16; unsigned char* rowp = O + (size_t)row * ldc + col0; const float r = rs[row] * osc;
#pragma unroll
                for (int bj = 0; bj < 2; ++bj) { const f32x4 v0 = acc[ai][bj][m][0] * r, v1 = acc[ai][bj][m][1] * r;
                    u32x2 w; w.x = cvt4_fp8(v0[0], v0[1], v0[2], v0[3]); w.y = cvt4_fp8(v1[0], v1[1], v1[2], v1[3]);
                    *(u32x2*)(rowp + bj * HALF) = w; } }
    }
};
struct EpiFp8 {
    static constexpr bool PERM = true;
    unsigned char* O; int ldc; float osc; int split, loff;
    __device__ __forceinline__ void operator()(const f32x4 (&acc)[2][2][4][2], const Unit& u, int wr, int wc, int fr, int fq) const {
        const int ln = lane_now();
        const int row0 = u.pm * BM + wr * 64 + (ln & 15), col0 = u.pn * BM + wc * 32 + 8 * (ln >> 4) + (u.pn >= split ? loff : 0);
#pragma unroll
        for (int ai = 0; ai < 2; ++ai)
#pragma unroll
            for (int m = 0; m < 4; ++m) { unsigned char* rowp = O + (size_t)(row0 + ai * HALF + m * 16) * ldc + col0;
#pragma unroll
                for (int bj = 0; bj < 2; ++bj) { const f32x4 v0 = acc[ai][bj][m][0] * osc, v1 = acc[ai][bj][m][1] * osc;
                    u32x2 w; w.x = cvt4_fp8(v0[0], v0[1], v0[2], v0[3]); w.y = cvt4_fp8(v1[0], v1[1], v1[2], v1[3]);
                    *(u32x2*)(rowp + bj * HALF) = w; } }
    }
};
struct EpiSwiGLU {
    static constexpr bool PERM = true;
    unsigned char* O; int ldc; float osc; const float* rs; const LAS float* rl;
    __device__ __forceinline__ void operator()(const f32x4 (&acc)[2][2][4][2], const Unit& u, int wr, int wc, int, int) const {
        const int ln = lane_now(), fr = ln & 15, fq = ln >> 4;
        const int row0 = u.pm * BM + wr * 64 + fr, col0 = u.pn * HALF + wc * 32 + 8 * fq;
#pragma unroll
        for (int ai = 0; ai < 2; ++ai)
#pragma unroll
            for (int m = 0; m < 4; ++m) { unsigned char* rowp = O + (size_t)(row0 + ai * HALF + m * 16) * ldc + col0; const float sg = osc * (rl ? rl[wr * 64 + fr + ai * HALF + m * 16] : rs[row0 + ai * HALF + m * 16]);
                const f32x2 c1 = (f32x2){-1.4426950408889634f * sg, -1.4426950408889634f * sg}, c2 = (f32x2){sg * sg * GU8_SCALE, sg * sg * GU8_SCALE};
                float o[8];
#pragma unroll
                for (int n = 0; n < 2; ++n)
#pragma unroll
                    for (int jp = 0; jp < 2; ++jp) { const f32x2 G = (f32x2){acc[ai][0][m][n][2 * jp], acc[ai][0][m][n][2 * jp + 1]}, U = (f32x2){acc[ai][1][m][n][2 * jp], acc[ai][1][m][n][2 * jp + 1]};
                        const f32x2 t = G * U, a = G * c1; const f32x2 d = (f32x2){__builtin_amdgcn_exp2f(a.x), __builtin_amdgcn_exp2f(a.y)} + (f32x2){1.0f, 1.0f};
                        const f32x2 r = (f32x2){__builtin_amdgcn_rcpf(d.x), __builtin_amdgcn_rcpf(d.y)}; const f32x2 q = (t * c2) * r; o[n * 4 + 2 * jp] = q.x; o[n * 4 + 2 * jp + 1] = q.y; }
                u32x2 w; w.x = cvt4_fp8(o[0], o[1], o[2], o[3]); w.y = cvt4_fp8(o[4], o[5], o[6], o[7]);
                *(u32x2*)rowp = w; }
    }
};
struct EpiGroup {
    static constexpr bool PERM = true;
    bf16_t* O; int ldc; int goff;
    __device__ __forceinline__ void operator()(const f32x4 (&acc)[2][2][4][2], const Unit& u, int wr, int wc, int fr, int fq) const {
        int ln; asm volatile("v_mbcnt_lo_u32_b32 %0, -1, 0\n\tv_mbcnt_hi_u32_b32 %0, -1, %0" : "=v"(ln));
        const int row0 = u.pm * BM + wr * 64 + (ln & 15), g = u.pn >> 1, half = u.pn & 1, c0 = 256 * half + wc * 32 + 8 * (ln >> 4);
        bf16_t* base = O + (size_t)row0 * ldc + PGW * g + c0 + (g >= 4 ? goff : 0);
#pragma unroll
        for (int ai = 0; ai < 2; ++ai)
#pragma unroll
            for (int m = 0; m < 4; ++m) { bf16_t* rowp = base + (size_t)(ai * HALF + m * 16) * ldc;
#pragma unroll
                for (int bj = 0; bj < 2; ++bj) { const f32x4 a0 = acc[ai][bj][m][0], a1 = acc[ai][bj][m][1];
                    u32x4 w; w.x = cvtpk(a0[0], a0[1]); w.y = cvtpk(a0[2], a0[3]); w.z = cvtpk(a1[0], a1[1]); w.w = cvtpk(a1[2], a1[3]);
                    if (bj == 0 || half == 0) *(u32x4*)(rowp + bj * HALF) = w; } }
    }
};

template <class Epi, bool FP8 = false>
__device__ __forceinline__ void gemm_phase(LAS unsigned char* lds, int tid, int wid, const Gemm g, const StaticOrder& S, const Epi& E) {
    const int lane = tid & 63, wr = wid >> 2, wc = wid & 3, fr = lane & 15, fq = lane >> 4;
    const int K = g.K, nt = K / BK;
    unsigned voffA[2], voffB[2];
#pragma unroll
    for (int i = 0; i < 2; ++i) { int R, C; stage_rc(tid * 16 + i * 8192, R, C); const int Rb = Epi::PERM ? ((R & ~31) + perm32(R & 31)) : R;
        voffA[i] = (unsigned)(R * g.lda + C) * 2u; voffB[i] = (unsigned)(Rb * g.ldb + C) * 2u; }
    const size_t kstep = (size_t)(BK * 2);
    const size_t hA = (size_t)HALF * g.lda * 2, hB = (size_t)HALF * g.ldb * 2;
    const unsigned ldsw = (unsigned)wid * 1024u;
    const int aoff = lds_byte(wr * 64 + fr, fq * 8), boff = lds_byte(wc * 32 + fr, fq * 8);
#define PG8_SA(b, h) (((b) * 2 + (h)) * HTB)
#define PG8_SB(b, h) ((4 + (b) * 2 + (h)) * HTB)
#define PG8_STAGE(bufoff, gbase, voff) do { _Pragma("unroll") for (int _i = 0; _i < 2; ++_i) \
        __builtin_amdgcn_global_load_lds((const unsigned*)((const char*)(gbase) + (voff)[_i]), (LAS unsigned*)(lds + (bufoff) + ldsw + _i * 8192), 16, 0, 0); } while (0)
#define PG8_LDA(dst, b, h) do { if constexpr (FP8) { _Pragma("unroll") for (int m = 0; m < 4; ++m) { const i32x4 lo_ = *(const LAS i32x4*)(lds + PG8_SA(b, h) + aoff + m * 2048), hi_ = *(const LAS i32x4*)(lds + PG8_SA(b, h) + aoff + m * 2048 + 1024); \
            dst##8[m] = __builtin_shufflevector(lo_, hi_, 0, 1, 2, 3, 4, 5, 6, 7); } } \
        else { _Pragma("unroll") for (int m = 0; m < 4; ++m) _Pragma("unroll") for (int k = 0; k < 2; ++k) dst[m][k] = *(const LAS bf16x8*)(lds + PG8_SA(b, h) + aoff + m * 2048 + k * 1024); } } while (0)
#define PG8_LDB(dst, b, h) do { if constexpr (FP8) { _Pragma("unroll") for (int n = 0; n < 2; ++n) { const i32x4 lo_ = *(const LAS i32x4*)(lds + PG8_SB(b, h) + boff + n * 2048), hi_ = *(const LAS i32x4*)(lds + PG8_SB(b, h) + boff + n * 2048 + 1024); \
            dst##8[n] = __builtin_shufflevector(lo_, hi_, 0, 1, 2, 3, 4, 5, 6, 7); } } \
        else { _Pragma("unroll") for (int n = 0; n < 2; ++n) _Pragma("unroll") for (int k = 0; k < 2; ++k) dst[n][k] = *(const LAS bf16x8*)(lds + PG8_SB(b, h) + boff + n * 2048 + k * 1024); } } while (0)
#define PG8_MMA(ai, bj, At, Bt) do { __builtin_amdgcn_s_setprio(1); \
        if constexpr (FP8) { _Pragma("unroll") for (int m = 0; m < 4; ++m) _Pragma("unroll") for (int n = 0; n < 2; ++n) \
            asm("v_mfma_f32_16x16x128_f8f6f4 %0, %1, %2, %0" : "+v"(acc[ai][bj][m][n]) : "v"(Bt##8[n]), "v"(At##8[m])); } \
        else { _Pragma("unroll") for (int m = 0; m < 4; ++m) _Pragma("unroll") for (int n = 0; n < 2; ++n) _Pragma("unroll") for (int k = 0; k < 2; ++k) \
            acc[ai][bj][m][n] = __builtin_amdgcn_mfma_f32_16x16x32_bf16(Bt[n][k], At[m][k], acc[ai][bj][m][n], 0, 0, 0); } \
        __builtin_amdgcn_s_setprio(0); } while (0)
#define PG8_MMA1(ai, bj, At, Bt, first) do { if constexpr (FP8) { __builtin_amdgcn_s_setprio(1); \
        if (first) { _Pragma("unroll") for (int m = 0; m < 4; ++m) _Pragma("unroll") for (int n = 0; n < 2; ++n) \
            asm("v_mfma_f32_16x16x128_f8f6f4 %0, %1, %2, 0" : "=&v"(acc[ai][bj][m][n]) : "v"(Bt##8[n]), "v"(At##8[m])); } \
        else { _Pragma("unroll") for (int m = 0; m < 4; ++m) _Pragma("unroll") for (int n = 0; n < 2; ++n) \
            asm("v_mfma_f32_16x16x128_f8f6f4 %0, %1, %2, %0" : "+v"(acc[ai][bj][m][n]) : "v"(Bt##8[n]), "v"(At##8[m])); } \
        __builtin_amdgcn_s_setprio(0); } else PG8_MMA(ai, bj, At, Bt); } while (0)
#define PG8_WAIT_V(n) asm volatile("s_waitcnt vmcnt(" #n ")" ::: "memory")
#define PG8_WAIT_L(n) asm volatile("s_waitcnt lgkmcnt(" #n ")" ::: "memory")
#define PG8_BAR __builtin_amdgcn_s_barrier()
#define PG8_SCHED __builtin_amdgcn_sched_barrier(0)
    Unit cur, nxt; int ui = 0;
    if (!S.next(0, cur)) return;
    f32x4 acc[2][2][4][2];
#pragma unroll
    for (int a = 0; a < 2; ++a)
#pragma unroll
        for (int b = 0; b < 2; ++b)
#pragma unroll
            for (int m = 0; m < 4; ++m)
#pragma unroll
                for (int n = 0; n < 2; ++n) acc[a][b][m][n] = (f32x4){0.f, 0.f, 0.f, 0.f};
    bf16x8 At[4][2], B0[2][2], B1[2][2];
    i32x8 At8[4], B08[2], B18[2];
    const char* cA = (const char*)g.A + ((size_t)cur.pm * BM * g.lda + (size_t)(cur.pn / g.a_div) * g.a_koff) * 2; const char* cB = (const char*)g.Bt + (size_t)cur.pn * BM * g.ldb * 2;
    PG8_STAGE(PG8_SB(0, 0), cB, voffB); PG8_STAGE(PG8_SB(0, 1), cB + hB, voffB); PG8_STAGE(PG8_SA(0, 0), cA, voffA); PG8_STAGE(PG8_SA(0, 1), cA + hA, voffA);
    PG8_STAGE(PG8_SB(1, 0), cB + kstep, voffB); PG8_STAGE(PG8_SA(1, 0), cA + kstep, voffA); PG8_STAGE(PG8_SB(1, 1), cB + hB + kstep, voffB);
    if (wr == 1) PG8_BAR;
    PG8_WAIT_V(8); PG8_BAR;
    PG8_WAIT_V(6); PG8_BAR;
    for (;;) {
        const bool has_next = S.next(ui + 1, nxt);
        const char* nA = has_next ? (const char*)g.A + ((size_t)nxt.pm * BM * g.lda + (size_t)(nxt.pn / g.a_div) * g.a_koff) * 2 : cA;
        const char* nB = has_next ? (const char*)g.Bt + (size_t)nxt.pn * BM * g.ldb * 2 : cB;
        for (int t = 0; t < nt; t += 2) {
            const bool last = (t == nt - 2);
            const char* a1 = cA + (size_t)(t + 1) * kstep;
            const char* a2 = last ? nA : cA + (size_t)(t + 2) * kstep; const char* b2 = last ? nB : cB + (size_t)(t + 2) * kstep;
            const char* a3 = a2 + kstep; const char* b3 = b2 + kstep;
            PG8_LDB(B0, 0, 0); PG8_LDB(B1, 0, 1); PG8_SCHED; PG8_LDA(At, 0, 0); PG8_STAGE(PG8_SA(1, 1), a1 + hA, voffA);
            PG8_WAIT_V(8); PG8_WAIT_L(0); PG8_BAR; PG8_MMA1(0, 0, At, B0, t == 0); PG8_MMA1(0, 1, At, B1, t == 0); PG8_BAR; PG8_SCHED;
            PG8_LDA(At, 0, 1); PG8_STAGE(PG8_SB(0, 0), b2, voffB); PG8_STAGE(PG8_SB(0, 1), b2 + hB, voffB); PG8_STAGE(PG8_SA(0, 0), a2, voffA);
            PG8_WAIT_V(8); PG8_WAIT_L(0); PG8_BAR; PG8_MMA1(1, 0, At, B0, t == 0); PG8_MMA1(1, 1, At, B1, t == 0); PG8_BAR; PG8_SCHED;
            PG8_LDB(B0, 1, 0); PG8_LDB(B1, 1, 1); PG8_SCHED; PG8_LDA(At, 1, 0); PG8_STAGE(PG8_SA(0, 1), a2 + hA, voffA);
            PG8_WAIT_V(8); PG8_WAIT_L(0); PG8_BAR; PG8_MMA(0, 0, At, B0); PG8_MMA(0, 1, At, B1); PG8_BAR; PG8_SCHED;
            PG8_LDA(At, 1, 1); PG8_STAGE(PG8_SB(1, 0), b3, voffB); PG8_STAGE(PG8_SB(1, 1), b3 + hB, voffB); PG8_STAGE(PG8_SA(1, 0), a3, voffA);
            PG8_WAIT_V(8); PG8_WAIT_L(0); PG8_BAR; PG8_MMA(1, 0, At, B0); PG8_MMA(1, 1, At, B1); PG8_BAR; PG8_SCHED;
        }
        if (wr == 0) PG8_BAR;
        if constexpr (FP8) asm volatile("s_nop 15\n\ts_nop 7" ::: "memory");
        E(acc, cur, wr, wc, fr, fq);
        if (!has_next) break;
        if constexpr (!FP8) {
#pragma unroll
        for (int a = 0; a < 2; ++a)
#pragma unroll
            for (int b = 0; b < 2; ++b)
#pragma unroll
                for (int m = 0; m < 4; ++m)
#pragma unroll
                    for (int n = 0; n < 2; ++n) acc[a][b][m][n] = (f32x4){0.f, 0.f, 0.f, 0.f}; }
        cur = nxt; cA = nA; cB = nB; ++ui;
        if (wr == 1) PG8_BAR;
    }
    PG8_WAIT_V(0);
    PG8_BAR;
#undef PG8_SA
#undef PG8_SB
#undef PG8_STAGE
#undef PG8_LDA
#undef PG8_LDB
#undef PG8_MMA
#undef PG8_MMA1
#undef PG8_WAIT_V
#undef PG8_WAIT_L
#undef PG8_BAR
#undef PG8_SCHED
}
}

struct Args { const float* in[23]; float* out; unsigned char* ws; int ph_lo, ph_hi, li, pad; };

typedef const __attribute__((address_space(4))) char* kargp_t;
struct Frame {
    LAS unsigned char* lds;
    int tid, lane, wave, G, bx;
    unsigned char* ws;
    kargp_t ka;
    __device__ __forceinline__ const float* in(int k) const { return *(const float* const __attribute__((address_space(4)))*)(ka + 8 * k); }
    __device__ __forceinline__ float* out() const { return *(float* const __attribute__((address_space(4)))*)(ka + 8 * 23); }
};
__device__ __forceinline__ Frame make_frame(LAS unsigned char* lds, int wv) {
    Frame F; F.lds = lds;
    asm volatile("" : "+s"(wv)); wv &= NWAVES - 1; const int ln = lane_now() & 63; F.tid = wv * 64 + ln; F.lane = ln; F.wave = wv;
    int g = gridDim.x, b = blockIdx.x; asm volatile("" : "+s"(g), "+s"(b)); F.G = g; F.bx = b;
    kargp_t ka = (kargp_t)__builtin_amdgcn_kernarg_segment_ptr(); asm volatile("" : "+s"(ka)); F.ka = ka;
    F.ws = *(unsigned char* const __attribute__((address_space(4)))*)(ka + 8 * 24);
    return F;
}

template <bool FP8 = false>
__device__ __forceinline__ void tr_item(const float* src, int ldn, int nvalid, int k0, int n0, void* dstv, int ldk, int drow0, LAS float* scr, int lane, const float* ksc = nullptr) {
    f32x4 ld_[8];
    const int ks = lane >> 3, n4 = 4 * (lane & 7);
#pragma unroll
    for (int i = 0; i < 8; ++i) ld_[i] = (n4 < nvalid) ? *(const f32x4*)(src + (size_t)(k0 + 8 * i + ks) * ldn + n0 + n4) : (f32x4){0.f, 0.f, 0.f, 0.f};
    if (ksc) {
#pragma unroll
        for (int i = 0; i < 8; ++i) ld_[i] *= ksc[k0 + 8 * i + ks]; }
#pragma unroll
    for (int i = 0; i < 8; ++i) { LAS float* w = scr + (8 * i + ks) * 33 + n4; w[0] = ld_[i].x; w[1] = ld_[i].y; w[2] = ld_[i].z; w[3] = ld_[i].w; }
    LGKM_WAIT(); asm volatile("" ::: "memory");
    const int c = lane & 7;
#pragma unroll
    for (int j = 0; j < 4; ++j) { const int n = (lane >> 3) + 8 * j; const LAS float* s = scr + (8 * c) * 33 + n;
        if constexpr (FP8) { u32x2 o; o.x = cvt4_fp8(s[0 * 33] * W8_SCALE, s[1 * 33] * W8_SCALE, s[2 * 33] * W8_SCALE, s[3 * 33] * W8_SCALE); o.y = cvt4_fp8(s[4 * 33] * W8_SCALE, s[5 * 33] * W8_SCALE, s[6 * 33] * W8_SCALE, s[7 * 33] * W8_SCALE);
            if (n < nvalid) *(u32x2*)((unsigned char*)dstv + (size_t)(drow0 + n) * ldk + k0 + 8 * c) = o; }
        else { u32x4 o; o.x = cvtpk(s[0 * 33], s[1 * 33]); o.y = cvtpk(s[2 * 33], s[3 * 33]); o.z = cvtpk(s[4 * 33], s[5 * 33]); o.w = cvtpk(s[6 * 33], s[7 * 33]);
            if (n < nvalid) *(u32x4*)((bf16_t*)dstv + (size_t)(drow0 + n) * ldk + k0 + 8 * c) = o; } }
    LGKM_WAIT(); asm volatile("" ::: "memory");
}
template <int OUT, bool XF32>
__device__ __forceinline__ void add_norm_row(const void* xin, const bf16_t* delta, bf16_t* xout, const float* gain, void* orow, int lane) {
    f32x4 v[8]; float s = 0.f;
#pragma unroll
    for (int j = 0; j < 8; ++j) {
        if constexpr (XF32) v[j] = ((const f32x4*)xin)[lane + 64 * j];
        else { const u32x2 xw = ((const u32x2*)xin)[lane + 64 * j]; v[j] = (f32x4){__builtin_bit_cast(float, xw.x << 16), __builtin_bit_cast(float, xw.x & 0xffff0000u), __builtin_bit_cast(float, xw.y << 16), __builtin_bit_cast(float, xw.y & 0xffff0000u)}; }
        const u32x2 dw = ((const u32x2*)delta)[lane + 64 * j];
        v[j].x += __builtin_bit_cast(float, dw.x << 16); v[j].y += __builtin_bit_cast(float, dw.x & 0xffff0000u); v[j].z += __builtin_bit_cast(float, dw.y << 16); v[j].w += __builtin_bit_cast(float, dw.y & 0xffff0000u);
        s += (v[j].x * v[j].x + v[j].y * v[j].y) + (v[j].z * v[j].z + v[j].w * v[j].w); }
    if (xout) {
#pragma unroll
        for (int j = 0; j < 8; ++j) { u32x2 o; o.x = cvtpk(v[j].x, v[j].y); o.y = cvtpk(v[j].z, v[j].w); ((u32x2*)xout)[lane + 64 * j] = o; } }
    const float rstd = 1.0f / sqrtf(wave_sum(s) * (1.0f / D) + EPS);
    if constexpr (OUT == 3) { if (lane == 0) *(float*)orow = rstd; return; }
#pragma unroll
    for (int j = 0; j < 8; ++j) { const f32x4 gv = ((const f32x4*)gain)[lane + 64 * j]; const f32x4 y = v[j] * rstd * gv;
        if constexpr (OUT == 0) ((unsigned*)orow)[lane + 64 * j] = cvt4_fp8(y.x, y.y, y.z, y.w);
        else if constexpr (OUT == 1) { u32x2 o; o.x = cvtpk(y.x, y.y); o.y = cvtpk(y.z, y.w); ((u32x2*)orow)[lane + 64 * j] = o; }
        else ((f32x4*)orow)[lane + 64 * j] = y; }
}
__device__ __forceinline__ void cast_row_rstd(const float* xrow, bf16_t* orow, float* rstd, int lane) {
    f32x4 v[8]; float s = 0.f;
#pragma unroll
    for (int j = 0; j < 8; ++j) { v[j] = ((const f32x4*)xrow)[lane + 64 * j]; s += (v[j].x * v[j].x + v[j].y * v[j].y) + (v[j].z * v[j].z + v[j].w * v[j].w); }
#pragma unroll
    for (int j = 0; j < 8; ++j) { u32x2 o; o.x = cvtpk(v[j].x, v[j].y); o.y = cvtpk(v[j].z, v[j].w); ((u32x2*)orow)[lane + 64 * j] = o; }
    const float r = 1.0f / sqrtf(wave_sum(s) * (1.0f / D) + EPS);
    if (lane == 0) *rstd = r;
}
__device__ __forceinline__ void cast_row_rstd2(const float* x0, const float* x1, bf16_t* o0, bf16_t* o1, float* r0, float* r1, int lane) {
    f32x4 va[8], vb[8]; float sa = 0.f, sb = 0.f;
#pragma unroll
    for (int j = 0; j < 8; ++j) { va[j] = ((const f32x4*)x0)[lane + 64 * j]; vb[j] = ((const f32x4*)x1)[lane + 64 * j]; }
#pragma unroll
    for (int j = 0; j < 8; ++j) { sa += (va[j].x * va[j].x + va[j].y * va[j].y) + (va[j].z * va[j].z + va[j].w * va[j].w); sb += (vb[j].x * vb[j].x + vb[j].y * vb[j].y) + (vb[j].z * vb[j].z + vb[j].w * vb[j].w);
        u32x2 oa; oa.x = cvtpk(va[j].x, va[j].y); oa.y = cvtpk(va[j].z, va[j].w); ((u32x2*)o0)[lane + 64 * j] = oa;
        u32x2 ob; ob.x = cvtpk(vb[j].x, vb[j].y); ob.y = cvtpk(vb[j].z, vb[j].w); ((u32x2*)o1)[lane + 64 * j] = ob; }
    const float ra = 1.0f / sqrtf(wave_sum(sa) * (1.0f / D) + EPS), rb = 1.0f / sqrtf(wave_sum(sb) * (1.0f / D) + EPS);
    if (lane == 0) { *r0 = ra; *r1 = rb; }
}
__device__ __forceinline__ void rms_row_bf16(const float* xrow, const float* gain, bf16_t* orow, int lane) {
    f32x4 v[8]; float s = 0.f;
#pragma unroll
    for (int j = 0; j < 8; ++j) { v[j] = ((const f32x4*)xrow)[lane + 64 * j]; s += (v[j].x * v[j].x + v[j].y * v[j].y) + (v[j].z * v[j].z + v[j].w * v[j].w); }
    const float rstd = 1.0f / sqrtf(wave_sum(s) * (1.0f / D) + EPS);
#pragma unroll
    for (int j = 0; j < 8; ++j) { const f32x4 gv = ((const f32x4*)gain)[lane + 64 * j];
        u32x2 o; o.x = cvtpk(v[j].x * rstd * gv.x, v[j].y * rstd * gv.y); o.y = cvtpk(v[j].z * rstd * gv.z, v[j].w * rstd * gv.w);
        ((u32x2*)orow)[lane + 64 * j] = o; }
}
__device__ __forceinline__ void qabs_fold_unit(const Frame& F, const float* w_uq, const float* w_uk, const float* q_norm, bf16_t* btq, int unit) {
    const int j = unit / 384, r = unit % 384, h = r / 32, cb = (r % 32) / 8, kb = r % 8, c0 = cb * 64, k0 = kb * 64;
    LAS float* Aw = (LAS float*)F.lds; LAS float* Bw = Aw + 64 * 132;
    const float* ukb = w_uk + (((size_t)j * NH + h) * KVL + c0) * HD;
    const float* uqb = w_uq + ((size_t)j * QL + k0) * (NH * HD) + h * HD;
#pragma unroll
    for (int i = 0; i < 4; ++i) { const int idx = F.tid + 512 * i, row = idx >> 5, c4 = idx & 31;
        const f32x4 a = *(const f32x4*)(ukb + (size_t)row * HD + 4 * c4), b = *(const f32x4*)(uqb + (size_t)row * (NH * HD) + 4 * c4) * q_norm[j * QL + k0 + row];
        *(LAS f32x4*)(Aw + row * 132 + 4 * c4) = a; *(LAS f32x4*)(Bw + row * 132 + 4 * c4) = b; }
    __syncthreads();
    const int c = F.lane, kg = F.wave;
    float acc[8];
#pragma unroll
    for (int e = 0; e < 8; ++e) acc[e] = 0.f;
#pragma unroll 4
    for (int d = 0; d < HD; d += 4) { const f32x4 a = *(const LAS f32x4*)(Aw + c * 132 + d);
#pragma unroll
        for (int e = 0; e < 8; ++e) { const f32x4 bv = *(const LAS f32x4*)(Bw + (kg * 8 + e) * 132 + d); acc[e] += (a.x * bv.x + a.y * bv.y) + (a.z * bv.z + a.w * bv.w); } }
    const float sc = 0.08838834764831845f;
    const float s8 = sc * QW8_SCALE; (void)btq;
    u32x2 o; o.x = cvt4_fp8(acc[0] * s8, acc[1] * s8, acc[2] * s8, acc[3] * s8); o.y = cvt4_fp8(acc[4] * s8, acc[5] * s8, acc[6] * s8, acc[7] * s8);
    *(u32x2*)(F.ws + WS_BT_QA8 + (size_t)j * QABS_W_ * QL + (size_t)(h * KVL + c0 + c) * QL + k0 + kg * 8) = o;
    __syncthreads();
}

__device__ __forceinline__ void phase_prologue(const Frame& F) {
    unsigned char* ws = F.ws;
    const float* x = F.in(0); const float* mem = F.in(1); const float* mixer_norm = F.in(2); const float* mem_norm = F.in(5);
    const float* w_mem_kv = F.in(6); const float* w_out = F.in(7); const float* w_gate = F.in(8); const float* w_up = F.in(9); const float* w_down = F.in(10);
    const float* w_in_attn = F.in(11); const float* w_uq = F.in(14); const float* w_uk = F.in(15); const float* w_uv = F.in(16); const float* w_idx_uq = F.in(17);
    const float* w_in_pool = F.in(20); const float* w_pool_group = F.in(21); const float* pool_scale = F.in(22);
    for (int u = F.bx; u < 768; u += F.G) qabs_fold_unit(F, w_uq, w_uk, F.in(12), (bf16_t*)(ws + WS_BT_Q), u);
    __syncthreads();
    LAS float* scr = (LAS float*)(F.lds + F.wave * 16384);
    const int gw = F.bx * NWAVES + F.wave, NGW = F.G * NWAVES;
    constexpr int I_G = (D / 64) * (DFF / 32), I_DN = (DFF / 64) * (D / 32), I_O = (D / 64) * (D / 32), I_MKV = (D / 64) * (1024 / 32);
    constexpr int I_IA = (D / 64) * 43, I_IQ = (QL / 64) * (1024 / 32), I_IP = (D / 64) * (D / 32);
    constexpr int PER_L = 2 * I_G + I_DN + I_O + I_MKV, PER_J = I_IA + I_IQ + I_IP;
    constexpr int NITEMS = 4 * PER_L + 2 * PER_J;
    for (int it = gw; it < NITEMS; it += NGW) {
        int r = it;
        if (r < 4 * PER_L) {
            const int l = r / PER_L; r -= l * PER_L;
            if (r < 2 * I_G) { const int up = r >= I_G; if (up) r -= I_G; const float* W = (up ? w_up : w_gate) + (size_t)l * D * DFF;
                const int nblk = DFF / 32, kb = r / nblk, nb = r % nblk, n0 = 32 * nb;
                tr_item<true>(W, DFF, 32, 64 * kb, n0, (unsigned char*)(ws + WS_BT_GU) + (size_t)l * SZ_BT_GU, D, 256 * (n0 / 128) + (n0 % 128) + (up ? 128 : 0), scr, F.lane, F.in(3) + (size_t)l * D); continue; }
            r -= 2 * I_G;
            if (r < I_DN) { const int nblk = D / 32, kb = r / nblk, nb = r % nblk;
                tr_item<true>(w_down + (size_t)l * DFF * D, D, 32, 64 * kb, 32 * nb, (unsigned char*)(ws + WS_BT_DOWN) + (size_t)l * D * DFF, DFF, 32 * nb, scr, F.lane); continue; }
            r -= I_DN;
            if (r < I_O) { const int nblk = D / 32, kb = r / nblk, nb = r % nblk;
                if (l & 1) { if (64 * kb < PW) tr_item(w_out + (size_t)l * D * D, D, 32, 64 * kb, 32 * nb, (bf16_t*)(ws + WS_BT_OUTT) + (size_t)(l >> 1) * PW, 2 * PW, 32 * nb, scr, F.lane);
                    else tr_item(w_out + (size_t)l * D * D, D, 32, 64 * kb, 32 * nb, (bf16_t*)(ws + WS_BT_OUT + (size_t)l * SZ_BT_OUT), D, 32 * nb, scr, F.lane); }
                else { if (64 * kb < PW) tr_item(w_out + (size_t)l * D * D, D, 32, 64 * kb, 32 * nb, (bf16_t*)(ws + WS_BT_OUTTD) + (size_t)(l >> 1) * PW, 2 * PW, 32 * nb, scr, F.lane);
                    else tr_item<true>(w_out + (size_t)l * D * D, D, 32, 64 * kb, 32 * nb, (unsigned char*)(ws + WS_BT_OUT + (size_t)l * SZ_BT_OUT) + (QABS_W_ - PW), YW8, 32 * nb, scr, F.lane); }
                continue; }
            r -= I_O;
            { const int nblk = 1024 / 32, kb = r / nblk, nb = r % nblk;
                tr_item(w_mem_kv + (size_t)l * D * 1024, 1024, 32, 64 * kb, 32 * nb, (bf16_t*)(ws + WS_BT_MEMKV), D, l * 1024 + 32 * nb, scr, F.lane); continue; }
        }
        r -= 4 * PER_L;
        const int j = r / PER_J; r -= j * PER_J;
        if (r < I_IA) { const int kb = r / 43, nb = r % 43, n0 = 32 * nb; const int nv = (ATTN_IN - n0) < 32 ? (ATTN_IN - n0) : 32;
            tr_item(w_in_attn + (size_t)j * D * ATTN_IN, ATTN_IN, nv, 64 * kb, n0, (bf16_t*)(ws + WS_BT_INATTN) + (size_t)j * ATTN_IN_PAD * D, D, n0, scr, F.lane, mixer_norm + (size_t)(2 * j) * D); continue; }
        r -= I_IA;
        if (r < I_IQ) { const int nblk = 1024 / 32, kb = r / nblk, nb = r % nblk;
            tr_item(w_idx_uq + (size_t)j * QL * 1024, 1024, 32, 64 * kb, 32 * nb, (bf16_t*)(ws + WS_BT_Q) + (size_t)j * NQ * QL, QL, QABS_W + 32 * nb, scr, F.lane, F.in(12) + (size_t)j * QL); continue; }
        r -= I_IQ;
        { const int nblk = D / 32, kb = r / nblk, nb = r % nblk;
            tr_item(w_in_pool + (size_t)j * D * D, D, 32, 64 * kb, 32 * nb, (bf16_t*)(ws + WS_BT_INPOOL) + (size_t)j * D * D, D, 32 * nb, scr, F.lane, mixer_norm + (size_t)(2 * j + 1) * D); }
    }
    const size_t gt = (size_t)F.bx * 512 + F.tid, GT = (size_t)F.G * 512;
    for (size_t i = gt; i < (size_t)2 * NH * KVL * HD / 8; i += GT) {
        const f32x4 a = ((const f32x4*)w_uv)[2 * i], b = ((const f32x4*)w_uv)[2 * i + 1];
        u32x4 o; o.x = cvtpk(a.x, a.y); o.y = cvtpk(a.z, a.w); o.z = cvtpk(b.x, b.y); o.w = cvtpk(b.z, b.w);
        ((u32x4*)(ws + WS_BT_UV))[i] = o;
    }
    for (size_t i = gt; i < (size_t)2 * 2048 * 48; i += GT) {
        const int j = (int)(i / (2048 * 48)), rem = (int)(i % (2048 * 48)), row = rem / 48, k8 = (rem % 48) * 8;
        const int pn = row / 256, rr = row % 256, g = pn >> 1, c384 = 256 * (pn & 1) + rr;
        float v[8];
#pragma unroll
        for (int e = 0; e < 8; ++e) v[e] = (c384 < PGW) ? w_pool_group[(((size_t)j * 4 + g) * PGW + c384) * PGW + (k8 + e)] * pool_scale[j * PW + g * PGW + k8 + e] : 0.f;
        u32x4 o; o.x = cvtpk(v[0], v[1]); o.y = cvtpk(v[2], v[3]); o.z = cvtpk(v[4], v[5]); o.w = cvtpk(v[6], v[7]);
        *(u32x4*)((bf16_t*)(ws + WS_BT_GROUP) + (size_t)j * 2048 * PGW + (size_t)row * PGW + k8) = o;
    }
    for (size_t i = gt; i < (size_t)2 * (ATTN_IN_PAD - ATTN_IN) * (D / 8); i += GT) {
        const int j = (int)(i / ((ATTN_IN_PAD - ATTN_IN) * (D / 8))), rem = (int)(i % ((ATTN_IN_PAD - ATTN_IN) * (D / 8))), row = ATTN_IN + rem / (D / 8), k8 = (rem % (D / 8)) * 8;
        *(u32x4*)((bf16_t*)(ws + WS_BT_INATTN) + (size_t)j * ATTN_IN_PAD * D + (size_t)row * D + k8) = (u32x4){0u, 0u, 0u, 0u};
    }
    for (int m = gw; m < 1024; m += NGW) rms_row_bf16(mem + (size_t)m * D, mem_norm, (bf16_t*)(ws + WS_MEMN) + (size_t)m * D, F.lane);
    { int m = gw;
      for (; m + NGW < M; m += 2 * NGW) cast_row_rstd2(x + (size_t)m * D, x + (size_t)(m + NGW) * D, (bf16_t*)(ws + WS_XRES) + (size_t)m * D, (bf16_t*)(ws + WS_XRES) + (size_t)(m + NGW) * D, (float*)(ws + WS_RSTD) + m, (float*)(ws + WS_RSTD) + m + NGW, F.lane);
      for (; m < M; m += NGW) cast_row_rstd(x + (size_t)m * D, (bf16_t*)(ws + WS_XRES) + (size_t)m * D, (float*)(ws + WS_RSTD) + m, F.lane); }
}

__device__ __forceinline__ void phase_postproj(const Frame& F, const float* q_norm, const float* kv_norm, const float* ikn, const float* ikb) {
    unsigned char* ws = F.ws;
    const float* proj = (const float*)(ws + WS_R0);
    const int gw = F.bx * NWAVES + F.wave, NGW = F.G * NWAVES, lane = F.lane;
    (void)q_norm; const f32x4 gk = ((const f32x4*)kv_norm)[lane];
    const float gi = ikn[lane], bi = ikb[lane];
    for (int m = gw; m < M; m += NGW) {
        const float* p = proj + (size_t)m * ATTN_IN_PAD;
        const f32x4 c = ((const f32x4*)(p + 512))[lane];
        const float kv = p[768 + lane];
        f32x4 qa = (f32x4){0.f, 0.f, 0.f, 0.f}; if (lane < 44) qa = ((const f32x4*)(p + 848))[lane];
        const float wraw = p[832 + (lane & (IH - 1))];
        float r1 = (c.x * c.x + c.y * c.y) + (c.z * c.z + c.w * c.w), r2 = kv, r3 = kv * kv;
#pragma unroll
        for (int o = 1; o < 64; o <<= 1) { const float t1 = __shfl_xor(r1, o), t2 = __shfl_xor(r2, o), t3 = __shfl_xor(r3, o); r1 += t1; r2 += t2; r3 += t3; }
        const float rk = 1.0f / sqrtf(r1 * (1.0f / KVL) + EPS);
        const float mu = r2 * (1.0f / IDM), var = fmaxf(r3 * (1.0f / IDM) - mu * mu, 0.f), ri = 1.0f / sqrtf(var + EPS);
        ((unsigned*)(ws + WS_CKV + (size_t)m * KVL))[lane] = cvt4_fp8(c.x * rk * gk.x, c.y * rk * gk.y, c.z * rk * gk.z, c.w * rk * gk.w);
        { const float y = (kv - mu) * ri * gi + bi; const unsigned pk = cvtpk(y, y);
          ((bf16_t*)(ws + WS_KIDX))[(size_t)(m >> 5) * 2048 + ((lane >> 3) * 32 + (m & 31)) * 8 + (lane & 7)] = (bf16_t)(pk & 0xffffu); }
        if (lane < IH) ((float*)(ws + WS_WIDX))[(size_t)m * IH + lane] = wraw * 0.03125f;
        if (lane < 44) { u32x2 o0; o0.x = cvtpk(qa.x, qa.y); o0.y = cvtpk(qa.z, qa.w); ((u32x2*)((bf16_t*)(ws + WS_QMEM) + (size_t)m * MW))[lane] = o0; }
    }
}

__device__ __forceinline__ float relu1(float x) { return __builtin_amdgcn_fmed3f(x, 0.0f, __builtin_inff()); }
__device__ __forceinline__ float xhalf_sum(float x) {
    const u32x2 r = __builtin_amdgcn_permlane32_swap(__builtin_bit_cast(unsigned, x), __builtin_bit_cast(unsigned, x), false, false);
    return __builtin_bit_cast(float, r[0]) + __builtin_bit_cast(float, r[1]);
}
__device__ __forceinline__ unsigned ordkey(float f) { const unsigned b = __builtin_bit_cast(unsigned, f); return (b & 0x80000000u) ? ~b : (b | 0x80000000u); }
__device__ __forceinline__ unsigned mbcnt64(unsigned long long m) { return __builtin_amdgcn_mbcnt_hi((unsigned)(m >> 32), __builtin_amdgcn_mbcnt_lo((unsigned)m, 0u)); }
__device__ __forceinline__ unsigned kvoff(unsigned row, unsigned ch) { return row * 512u + ((ch ^ (row & 15u)) << 4); }

__device__ __forceinline__ void phase_dsa(const Frame& F, bool dummy) {
    unsigned char* ws = F.ws;
    const bf16_t* qidx = (const bf16_t*)(ws + WS_R0 + R0_B);
    const bf16_t* kidx = (const bf16_t*)(ws + WS_KIDX);
    const float* widx = (const float*)(ws + WS_WIDX);
    bf16_t* qabs = (bf16_t*)(ws + WS_R0);
    const int lane = F.lane, wave = F.wave, l31 = lane & 31, h5 = lane >> 5, l15 = lane & 15, g4 = lane >> 4;
    LAS float* scores = (LAS float*)F.lds;
    LAS unsigned short* idxl = (LAS unsigned short*)(F.lds + LDS_IDX_OFF) + wave * IDX_STRIDE;
    LAS unsigned char* region = F.lds + wave * 16384;
    const unsigned region_a = (unsigned)(size_t)region;
    for (int ui = 0; ; ++ui) {
        const int unit = ui * F.G + (((ui & 1) && !(F.G & 3)) ? ((F.G - 1 - F.bx) & ~3) | (F.bx & 3) : F.bx); if (unit >= M / 8) break;
        const int b = unit & 3, tb = unit >> 2, t0 = tb * 8, tok0 = b * T + t0;
        __syncthreads();
        for (int rp1 = 0; rp1 < (DSA_PROBE == 1 ? 2 : 1); ++rp1) {
            const int nkt = (t0 + 8 + 31) >> 5;
            const bf16_t* kb = kidx + (size_t)(b * T) * IDM + (h5 * 32 + l31) * 8;
            bf16x8 aq[4][4]; float wv[4][16];
#pragma unroll
            for (int rg = 0; rg < 4; ++rg) {
                const int q0 = tok0 + 2 * rg;
#pragma unroll
                for (int ks = 0; ks < 4; ++ks) aq[rg][ks] = *(const bf16x8*)(qidx + (size_t)(q0 + (l31 >> 4)) * 1024 + l15 * 64 + 16 * ks + 8 * h5);
#pragma unroll
                for (int qq = 0; qq < 2; ++qq)
#pragma unroll
                    for (int hh = 0; hh < 2; ++hh) { const f32x4 w4 = *(const f32x4*)(widx + (size_t)(q0 + qq) * IH + 8 * hh + 4 * h5);
                        wv[rg][8 * qq + 4 * hh + 0] = w4.x; wv[rg][8 * qq + 4 * hh + 1] = w4.y; wv[rg][8 * qq + 4 * hh + 2] = w4.z; wv[rg][8 * qq + 4 * hh + 3] = w4.w; }
            }
            bf16x8 bk[4];
            { const int kt0 = wave < nkt ? wave : 0;
#pragma unroll
              for (int ks = 0; ks < 4; ++ks) bk[ks] = *(const bf16x8*)(kb + (size_t)kt0 * 2048 + 512 * ks); }
            for (int kt = wave; kt < nkt; kt += NWAVES) {
                bf16x8 bn[4];
                const int ktn = (kt + NWAVES < nkt) ? kt + NWAVES : kt;
#pragma unroll
                for (int ks = 0; ks < 4; ++ks) bn[ks] = *(const bf16x8*)(kb + (size_t)ktn * 2048 + 512 * ks);
#pragma unroll
                for (int hp = 0; hp < 2; ++hp) {
                    f32x16 acc[2];
#pragma unroll
                    for (int rg = 0; rg < 2; ++rg) {
#pragma unroll
                        for (int r = 0; r < 16; ++r) acc[rg][r] = 0.f;
#pragma unroll
                        for (int ks = 0; ks < 4; ++ks) acc[rg] = __builtin_amdgcn_mfma_f32_32x32x16_bf16(aq[2 * hp + rg][ks], bk[ks], acc[rg], 0, 0, 0);
                    }
                    float sA[2], sB[2];
#pragma unroll
                    for (int rg = 0; rg < 2; ++rg) { sA[rg] = 0.f; sB[rg] = 0.f;
#pragma unroll
                        for (int r = 0; r < 8; ++r) { sA[rg] += wv[2 * hp + rg][r] * relu1(acc[rg][r]); sB[rg] += wv[2 * hp + rg][8 + r] * relu1(acc[rg][8 + r]); } }
                    const float tA0 = __shfl_xor(sA[0], 32), tB0 = __shfl_xor(sB[0], 32), tA1 = __shfl_xor(sA[1], 32), tB1 = __shfl_xor(sB[1], 32);
                    scores[(4 * hp + h5) * 4096 + 32 * kt + l31] = h5 ? sB[0] + tB0 : sA[0] + tA0;
                    scores[(4 * hp + 2 + h5) * 4096 + 32 * kt + l31] = h5 ? sB[1] + tB1 : sA[1] + tA1;
                }
#pragma unroll
                for (int ks = 0; ks < 4; ++ks) bk[ks] = bn[ks];
            }
        }
        __syncthreads();
        const int t = t0 + wave, tok = tok0 + wave, nvalid = t + 1, cnt = nvalid < TOPK ? nvalid : TOPK;
        i32x8 bq8[2];
        { int lnq = F.lane; asm volatile("" : "+v"(lnq)); const int hq = lnq & 15, gq = lnq >> 4;
          const unsigned char* q8row = (const unsigned char*)qabs + (size_t)tok * QABS_W + hq * KVL + 32 * gq;
#pragma unroll
          for (int s = 0; s < 2; ++s) { i32x4 lo = (i32x4){0, 0, 0, 0}, hi = lo; if (hq < NH) { lo = *(const i32x4*)(q8row + 128 * s); hi = *(const i32x4*)(q8row + 128 * s + 16); }
              bq8[s] = __builtin_shufflevector(lo, hi, 0, 1, 2, 3, 4, 5, 6, 7); } }
        for (int rp2 = 0; rp2 < (DSA_PROBE == 2 ? 2 : 1); ++rp2)
        if (nvalid <= TOPK) {
#pragma unroll
            for (int i = 0; i < 4; ++i) { const int j = lane + 64 * i; idxl[j] = (unsigned short)(j <= t ? j : 0); }
        } else {
            unsigned u[64];
            int ln2 = F.lane; asm volatile("" : "+v"(ln2));
#pragma unroll
            for (int g8 = 0; g8 < 8; ++g8) {
                if (64 * 8 * g8 <= t) {
#pragma unroll
                    for (int i = 8 * g8; i < 8 * g8 + 8; ++i) { const int j = 64 * i + ln2; const float sv = scores[wave * 4096 + j]; u[i] = (j <= t) ? ordkey(sv) : 0u; }
                } else {
#pragma unroll
                    for (int i = 8 * g8; i < 8 * g8 + 8; ++i) u[i] = 0u;
                } }
            unsigned kmx = 0u, kmn = 0xffffffffu;
#pragma unroll
            for (int g8 = 0; g8 < 8; ++g8) if (64 * 8 * g8 <= t) {
#pragma unroll
                for (int i = 8 * g8; i < 8 * g8 + 8; ++i) { kmx = u[i] > kmx ? u[i] : kmx; const unsigned v = u[i] ? u[i] : 0xffffffffu; kmn = v < kmn ? v : kmn; } }
#pragma unroll
            for (int o = 1; o < 64; o <<= 1) { const unsigned a = (unsigned)__shfl_xor((int)kmx, o), bb = (unsigned)__shfl_xor((int)kmn, o); kmx = a > kmx ? a : kmx; kmn = bb < kmn ? bb : kmn; }
            unsigned lo = __builtin_amdgcn_readfirstlane(kmn), hi = __builtin_amdgcn_readfirstlane(kmx) + 1u, Tk = lo;
            int clo = nvalid, chi = 0, side = 0;
            for (int it = 0; it < 128 && hi - lo > 1u; ++it) {
                const unsigned blo = (lo & 0x80000000u) ? (lo ^ 0x80000000u) : ~lo, bhi = (hi & 0x80000000u) ? (hi ^ 0x80000000u) : ~hi;
                const float flo = __builtin_bit_cast(float, blo), fhi = __builtin_bit_cast(float, bhi);
                float wa = (float)clo - ((float)TOPK - 0.5f), wb = ((float)TOPK - 0.5f) - (float)chi;
                if (side >= 2) wb *= 0.5f; if (side <= -2) wa *= 0.5f;
                const float frac = it ? wa / (wa + wb) : 0.443f + 0.067f * ((float)(31 - __clz(nvalid)) - 7.5f);
                const float fc = flo + (fhi - flo) * frac;
                unsigned cand = ordkey(fc);
                cand = (cand <= lo || !(fc == fc)) ? lo + 1u : cand; cand = cand >= hi ? hi - 1u : cand;
                cand = (unsigned)__builtin_amdgcn_readfirstlane((int)cand);
                int c = 0;
#pragma unroll
                for (int g8 = 0; g8 < 8; ++g8) if (64 * 8 * g8 <= t) {
#pragma unroll
                    for (int i = 8 * g8; i < 8 * g8 + 8; ++i) c += __popcll(__ballot(u[i] >= cand));
                    __builtin_amdgcn_sched_barrier(0);
                }
                if (c >= TOPK) { lo = cand; clo = c; side = side > 0 ? side + 1 : 1; } else { hi = cand; chi = c; side = side < 0 ? side - 1 : -1; }
                if (c == TOPK) break;
            }
            Tk = lo;
            if (clo != TOPK && hi - lo > 1u) {
                Tk = 0u;
                for (int bit = 31; bit >= 0; --bit) {
                    const unsigned cand = Tk | (1u << bit); int c = 0;
#pragma unroll
                    for (int g8 = 0; g8 < 8; ++g8) if (64 * 8 * g8 <= t) {
#pragma unroll
                        for (int i = 8 * g8; i < 8 * g8 + 8; ++i) c += __popcll(__ballot(u[i] >= cand));
                        __builtin_amdgcn_sched_barrier(0);
                    }
                    if (c >= TOPK) Tk = cand;
                    if (c == TOPK) break;
                }
            }
            if (clo == TOPK) {
                int ln2c = F.lane; asm volatile("" : "+v"(ln2c));
                unsigned Tk3 = __builtin_amdgcn_readfirstlane(Tk); asm volatile("" : "+s"(Tk3));
                int base = 0;
#pragma unroll
                for (int g8 = 0; g8 < 8; ++g8) if (64 * 8 * g8 <= t) {
#pragma unroll
                    for (int i = 8 * g8; i < 8 * g8 + 8; ++i) {
                        const bool sel = u[i] >= Tk3; const unsigned long long mk = __ballot(sel);
                        const int pos = __builtin_amdgcn_mbcnt_hi((unsigned)(mk >> 32), __builtin_amdgcn_mbcnt_lo((unsigned)mk, (unsigned)base));
                        idxl[sel ? pos : TOPK + ln2c] = (unsigned short)(64 * i + ln2c);
                        base += __popcll(mk);
                    }
                    __builtin_amdgcn_sched_barrier(0);
                }
            } else {
                int cg = 0, ce = 0;
    #pragma unroll
                for (int g8 = 0; g8 < 8; ++g8) if (64 * 8 * g8 <= t) {
    #pragma unroll
                    for (int i = 8 * g8; i < 8 * g8 + 8; ++i) { cg += (u[i] > Tk) ? 1 : 0; ce += (u[i] == Tk) ? 1 : 0; } }
                int Pg = cg, Pe = ce;
    #pragma unroll
                for (int o = 1; o < 64; o <<= 1) { const int tg = __shfl_up(Pg, o), te = __shfl_up(Pe, o); if (lane >= o) { Pg += tg; Pe += te; } }
                int ln2b = F.lane; asm volatile("" : "+v"(ln2b));
                unsigned Tk2 = __builtin_amdgcn_readfirstlane(Tk); asm volatile("" : "+s"(Tk2));
                const int ngt = __builtin_amdgcn_readlane(Pg, 63), kk = TOPK - ngt;
                int pos_g = Pg - cg, pos_e = ngt + (Pe - ce);
    #pragma unroll
                for (int g8 = 0; g8 < 8; ++g8) if (64 * 8 * g8 <= t) {
    #pragma unroll
                    for (int i = 8 * g8; i < 8 * g8 + 8; ++i) {
                        const bool g = u[i] > Tk2, e = u[i] == Tk2;
                        const int trash = TOPK + ln2b;
                        idxl[(g && pos_g < TOPK) ? pos_g : ((e && pos_e < TOPK) ? pos_e : trash)] = (unsigned short)(64 * i + ln2b);
                        pos_g += g ? 1 : 0; pos_e += e ? 1 : 0;
                    } }
                    }
        }
        LGKM_WAIT();
        for (int rp3 = 0; rp3 < (DSA_PROBE == 3 ? 2 : 1); ++rp3) {
            int ln3 = F.lane; asm volatile("" : "+v"(ln3));
            const int lane = ln3, l31 = lane & 31, h5 = lane >> 5, l15 = lane & 15, g4 = lane >> 4;
            f32x4 o[16];
#pragma unroll
            for (int ct = 0; ct < 16; ++ct) o[ct] = (f32x4){0.f, 0.f, 0.f, 0.f};
            float m_run = -INFINITY, l_run = 0.f;
            const unsigned char* ckvb = (const unsigned char*)(ws + WS_CKV) + (size_t)b * T * KVL;
            const int nch = (cnt + 31) >> 5;
#define DSA_GATHER(CH, BUF) do { const u32x4 kw_ = *(const LAS u32x4*)(idxl + (CH) * 32 + g4 * 8); const unsigned kk_[4] = {kw_.x, kw_.y, kw_.z, kw_.w}; \
                _Pragma("unroll") for (int i = 0; i < 8; ++i) { const unsigned key = (i & 1) ? (kk_[i >> 1] >> 16) : (kk_[i >> 1] & 0xffffu); \
                    const unsigned char* src_ = ckvb + (size_t)(key * (unsigned)KVL) + ((((unsigned)l15) ^ ((unsigned)(4 * i + g4) & 15u)) << 4); \
                    __builtin_amdgcn_global_load_lds((const unsigned*)src_, (LAS unsigned*)(region + (BUF) * 8192 + i * 1024), 16, 0, 0); } } while (0)
            const unsigned qr = ((unsigned)l15 >> 1) & 3u, r15 = 4u * g4 + qr;
            const unsigned trbase = region_a + (r15 + 16u * ((unsigned)l15 >> 3)) * 256u + 8u * ((unsigned)l15 & 1u);
            unsigned sa[4];
#pragma unroll
            for (int s = 0; s < 2; ++s)
#pragma unroll
                for (int e = 0; e < 2; ++e) sa[2 * s + e] = region_a + (unsigned)l15 * 256u + ((((unsigned)(8 * s + 2 * g4 + e)) ^ (unsigned)l15) << 4);
            LGKM_WAIT();
            DSA_GATHER(0, 0);
            for (int ch = 0; ch < nch; ++ch) {
                const unsigned cur = (unsigned)(ch & 1) * 8192u;
                if (ch + 1 < nch) { LGKM_WAIT(); DSA_GATHER(ch + 1, (ch + 1) & 1); asm volatile("s_waitcnt vmcnt(8)" ::: "memory"); }
                else asm volatile("s_waitcnt vmcnt(0)" ::: "memory");
                i32x4 ar[8];
#pragma unroll
                for (int s = 0; s < 2; ++s) {
                    const unsigned a0 = sa[2 * s] + cur, a1 = sa[2 * s + 1] + cur;
                    asm volatile("ds_read_b128 %0, %4\n\tds_read_b128 %1, %5\n\tds_read_b128 %2, %4 offset:4096\n\tds_read_b128 %3, %5 offset:4096"
                                 : "=&v"(ar[2 * s]), "=&v"(ar[2 * s + 1]), "=&v"(ar[4 + 2 * s]), "=&v"(ar[4 + 2 * s + 1]) : "v"(a0), "v"(a1) : "memory");
                }
                long vt[16];
#pragma unroll
                for (int c = 0; c < 16; c += 4) {
                    unsigned ta[4];
#pragma unroll
                    for (int e = 0; e < 4; ++e) ta[e] = trbase + cur + ((((unsigned)(c + e)) ^ r15) << 4);
                    asm volatile("ds_read_b64_tr_b8 %0, %4\n\tds_read_b64_tr_b8 %1, %5\n\tds_read_b64_tr_b8 %2, %6\n\tds_read_b64_tr_b8 %3, %7"
                                 : "=&v"(vt[c]), "=&v"(vt[c + 1]), "=&v"(vt[c + 2]), "=&v"(vt[c + 3]) : "v"(ta[0]), "v"(ta[1]), "v"(ta[2]), "v"(ta[3]) : "memory");
                }
                asm volatile("s_waitcnt lgkmcnt(0)" ::: "memory"); __builtin_amdgcn_sched_barrier(0);
                f32x4 st[2];
#pragma unroll
                for (int tl = 0; tl < 2; ++tl) { st[tl] = (f32x4){0.f, 0.f, 0.f, 0.f};
#pragma unroll
                    for (int s = 0; s < 2; ++s) { const i32x8 a8 = __builtin_shufflevector(ar[4 * tl + 2 * s], ar[4 * tl + 2 * s + 1], 0, 1, 2, 3, 4, 5, 6, 7);
                        asm volatile("s_nop 1\n\tv_mfma_f32_16x16x128_f8f6f4 %0, %1, %2, %0" : "+v"(st[tl]) : "v"(a8), "v"(bq8[s])); } }
                asm volatile("s_nop 15\n\ts_nop 3" ::: "memory"); __builtin_amdgcn_sched_barrier(0);
                float mx = -INFINITY;
#pragma unroll
                for (int tl = 0; tl < 2; ++tl)
#pragma unroll
                    for (int r = 0; r < 4; ++r) { const int pos = ch * 32 + r * 8 + 4 * tl + g4; st[tl][r] = (pos >= cnt) ? -INFINITY : st[tl][r] * (1.0f / QA8_SCALE); mx = fmaxf(mx, st[tl][r]); }
                if (__any(mx > m_run + 5.0f)) {
                    mx = fmaxf(mx, __shfl_xor(mx, 16)); mx = fmaxf(mx, __shfl_xor(mx, 32));
                    const float m_new = (mx > m_run + 5.0f) ? mx : m_run, alpha = __expf(m_run - m_new);
                    l_run *= alpha; m_run = m_new;
#pragma unroll
                    for (int ct = 0; ct < 16; ++ct) o[ct] *= alpha;
                }
                float p[8]; float ps = 0.f;
#pragma unroll
                for (int tl = 0; tl < 2; ++tl)
#pragma unroll
                    for (int r = 0; r < 4; ++r) { p[tl * 4 + r] = __expf(st[tl][r] - m_run); ps += p[tl * 4 + r]; }
                l_run += ps;
                const long bp = (long)(((unsigned long long)cvt4_fp8(p[4], p[5], p[6], p[7]) << 32) | (unsigned long long)cvt4_fp8(p[0], p[1], p[2], p[3]));
#pragma unroll
                for (int c = 0; c < 16; ++c) o[c] = __builtin_amdgcn_mfma_f32_16x16x32_fp8_fp8(vt[c], bp, o[c], 0, 0, 0);
            }
#undef DSA_GATHER
            float l = l_run; l += __shfl_xor(l, 16); l += __shfl_xor(l, 32);
            const float inv = Y8_SCALE / l;
            if (l15 < NH) {
                unsigned char* orow = ((dummy || (DSA_PROBE == 3 && rp3 == 0)) ? ws + WS_H + (size_t)(tok & 8191) * QABS_W + l15 * KVL : ws + WS_R0 + R0_C + (size_t)tok * YW8 + l15 * KVL) + 4 * g4;
#pragma unroll
                for (int ct = 0; ct < 16; ++ct) *(unsigned*)(orow + 16 * ct) = cvt4_fp8(o[ct][0] * inv, o[ct][1] * inv, o[ct][2] * inv, o[ct][3] * inv);
            }
        }
    }
    __syncthreads();
}

__device__ __forceinline__ unsigned off_b(unsigned row, unsigned ch) { return 256u * row + 16u * (ch ^ (((row & 3u) << 2) | ((row >> 2) & 3u))); }
template <bool Y16>
__device__ __forceinline__ void phase_memattn(const Frame& F, int layer) {
    unsigned char* ws = F.ws;
    const bf16_t* qmem = (const bf16_t*)(ws + WS_QMEM);
    const bf16_t* mkv = (const bf16_t*)(ws + WS_MKV);
    unsigned char* ymix = ws + WS_R0 + R0_C;
    const int lane = F.lane, wave = F.wave, l15 = lane & 15, g4 = lane >> 4;
    LAS unsigned char* Kl = F.lds; LAS unsigned char* Vl = F.lds + 65536;
    const unsigned Vl_a = (unsigned)(size_t)Vl;
    int staged = -1;
    for (int unit = F.bx; unit < 512; unit += F.G) {
        const int combo = unit & 15, qb = unit >> 4, b = combo >> 2, head = combo & 3;
        if (combo != staged) {
            __syncthreads();
            const bf16_t* kb = mkv + (size_t)(b * NMEM) * 4096 + layer * 1024 + head * HD;
#pragma unroll
            for (int i = 0; i < 8; ++i) { const int idx = F.tid + 512 * i, row = idx >> 4, ch = idx & 15;
                const u32x4 kv = *(const u32x4*)(kb + (size_t)row * 4096 + 8 * ch), vv = *(const u32x4*)(kb + (size_t)row * 4096 + 512 + 8 * ch);
                *(LAS u32x4*)(Kl + off_b(row, ch)) = kv; *(LAS u32x4*)(Vl + off_b(row, ch)) = vv; }
            __syncthreads();
            staged = combo;
        }
        const int tok = b * T + qb * 128 + wave * 16 + l15;
        bf16x8 bq[4];
#pragma unroll
        for (int s = 0; s < 4; ++s) bq[s] = *(const bf16x8*)(qmem + (size_t)tok * MW + head * HD + 32 * s + 8 * g4);
        f32x4 st[16];
        {
            const unsigned Kl_a = (unsigned)(size_t)Kl, fxk = (((unsigned)l15 & 3u) << 2) | (((unsigned)l15 >> 2) & 3u);
            unsigned ka[4];
#pragma unroll
            for (int s = 0; s < 4; ++s) ka[s] = Kl_a + 256u * (unsigned)l15 + 16u * (((unsigned)(4 * s + g4)) ^ fxk);
#define MEM_K4(RB0) { bf16x8 kf[16]; _Pragma("unroll") for (int s = 0; s < 4; ++s) \
                asm volatile("ds_read_b128 %0, %4 offset:%c5\n\tds_read_b128 %1, %4 offset:%c6\n\tds_read_b128 %2, %4 offset:%c7\n\tds_read_b128 %3, %4 offset:%c8" \
                    : "=&v"(kf[s]), "=&v"(kf[4 + s]), "=&v"(kf[8 + s]), "=&v"(kf[12 + s]) : "v"(ka[s]), "i"(4096 * (RB0)), "i"(4096 * (RB0) + 4096), "i"(4096 * (RB0) + 8192), "i"(4096 * (RB0) + 12288) : "memory"); \
              asm volatile("s_waitcnt lgkmcnt(0)" ::: "memory"); __builtin_amdgcn_sched_barrier(0); \
              _Pragma("unroll") for (int r4 = 0; r4 < 4; ++r4) { st[(RB0) + r4] = (f32x4){0.f, 0.f, 0.f, 0.f}; \
                _Pragma("unroll") for (int s = 0; s < 4; ++s) st[(RB0) + r4] = __builtin_amdgcn_mfma_f32_16x16x32_bf16(kf[4 * r4 + s], bq[s], st[(RB0) + r4], 0, 0, 0); } }
            MEM_K4(0) MEM_K4(4) MEM_K4(8) MEM_K4(12)
#undef MEM_K4
        }
        float mx = -INFINITY;
#pragma unroll
        for (int rb = 0; rb < 16; ++rb)
#pragma unroll
            for (int r = 0; r < 4; ++r) mx = fmaxf(mx, st[rb][r]);
        mx = fmaxf(mx, __shfl_xor(mx, 16)); mx = fmaxf(mx, __shfl_xor(mx, 32));
        const float sc = 0.08838834764831845f; float ps = 0.f;
#pragma unroll
        for (int rb = 0; rb < 16; ++rb)
#pragma unroll
            for (int r = 0; r < 4; ++r) { st[rb][r] = __expf((st[rb][r] - mx) * sc); ps += st[rb][r]; }
        ps += __shfl_xor(ps, 16); ps += __shfl_xor(ps, 32);
        const float inv = (Y16 ? 1.0f : Y8_SCALE) / ps;
        bf16x8 bp[8];
#pragma unroll
        for (int ks = 0; ks < 8; ++ks) { u32x4 w; w.x = cvtpk(st[2 * ks][0], st[2 * ks][1]); w.y = cvtpk(st[2 * ks][2], st[2 * ks][3]); w.z = cvtpk(st[2 * ks + 1][0], st[2 * ks + 1][1]); w.w = cvtpk(st[2 * ks + 1][2], st[2 * ks + 1][3]);
            bp[ks] = __builtin_bit_cast(bf16x8, w); }
        const unsigned q4 = (unsigned)l15 >> 2, p4 = (unsigned)lane & 3u, fx = (q4 << 2) | (unsigned)g4;
        unsigned char* orow = Y16 ? ymix + ((size_t)tok * D + PW + head * HD + 4 * g4) * 2 : ymix + (size_t)tok * YW8 + QABS_W_ + head * HD + 4 * g4;
#pragma unroll
        for (int c = 0; c < 8; ++c) {
            f32x4 oc = (f32x4){0.f, 0.f, 0.f, 0.f};
            const unsigned a0 = Vl_a + 256u * (4u * g4 + q4) + 16u * ((2u * c + (p4 >> 1)) ^ fx) + 8u * (p4 & 1u);
            s16x4 vr[16];
#define MEM_TR4(KS) asm volatile("ds_read_b64_tr_b16 %0, %4 offset:%c5\n\tds_read_b64_tr_b16 %1, %4 offset:%c6\n\tds_read_b64_tr_b16 %2, %4 offset:%c7\n\tds_read_b64_tr_b16 %3, %4 offset:%c8" \
                : "=&v"(vr[2 * (KS)]), "=&v"(vr[2 * (KS) + 1]), "=&v"(vr[2 * (KS) + 2]), "=&v"(vr[2 * (KS) + 3]) : "v"(a0), "i"(8192 * (KS)), "i"(8192 * (KS) + 4096), "i"(8192 * (KS) + 8192), "i"(8192 * (KS) + 12288) : "memory");
            MEM_TR4(0) MEM_TR4(2) MEM_TR4(4) MEM_TR4(6)
#undef MEM_TR4
            asm volatile("s_waitcnt lgkmcnt(0)" ::: "memory"); __builtin_amdgcn_sched_barrier(0);
#pragma unroll
            for (int ks = 0; ks < 8; ++ks) { const bf16x8 af = __builtin_shufflevector(vr[2 * ks], vr[2 * ks + 1], 0, 1, 2, 3, 4, 5, 6, 7); oc = __builtin_amdgcn_mfma_f32_16x16x32_bf16(af, bp[ks], oc, 0, 0, 0); }
            if constexpr (Y16) { u32x2 o; o.x = cvtpk(oc[0] * inv, oc[1] * inv); o.y = cvtpk(oc[2] * inv, oc[3] * inv); *(u32x2*)(orow + 32 * c) = o; }
            else *(unsigned*)(orow + 16 * c) = cvt4_fp8(oc[0] * inv, oc[1] * inv, oc[2] * inv, oc[3] * inv);
        }
    }
    __syncthreads();
}

template <int W>
__device__ __forceinline__ void pool_item(const bf16_t* U, bf16_t* Y, int tok0, int t0, int c8) {
    constexpr int NR = W - 1 + 8;
    u32x4 rows[NR];
#pragma unroll
    for (int k = 0; k < NR; ++k) { const int dt = k - (W - 1); const bool ok = t0 + dt >= 0;
        const u32x4 v = *(const u32x4*)(U + (size_t)(tok0 + (ok ? dt : 0)) * PW + c8);
        rows[k] = (u32x4){ok ? v.x : 0u, ok ? v.y : 0u, ok ? v.z : 0u, ok ? v.w : 0u}; }
    float s[8];
#pragma unroll
    for (int e = 0; e < 8; ++e) s[e] = 0.f;
#pragma unroll
    for (int k = 0; k < W - 1; ++k) { const unsigned vv[4] = {rows[k].x, rows[k].y, rows[k].z, rows[k].w};
#pragma unroll
        for (int e = 0; e < 4; ++e) { s[2 * e] += __builtin_bit_cast(float, vv[e] << 16); s[2 * e + 1] += __builtin_bit_cast(float, vv[e] & 0xffff0000u); } }
#pragma unroll
    for (int ti = 0; ti < 8; ++ti) {
        const unsigned nw[4] = {rows[W - 1 + ti].x, rows[W - 1 + ti].y, rows[W - 1 + ti].z, rows[W - 1 + ti].w};
        float own[8];
#pragma unroll
        for (int e = 0; e < 4; ++e) { own[2 * e] = __builtin_bit_cast(float, nw[e] << 16); own[2 * e + 1] = __builtin_bit_cast(float, nw[e] & 0xffff0000u); s[2 * e] += own[2 * e]; s[2 * e + 1] += own[2 * e + 1]; }
        const int t = t0 + ti, n = (t + 1) < W ? (t + 1) : W; const float rn = 1.0f / (float)n;
        u32x4 o; o.x = cvtpk(s[0] * rn - own[0], s[1] * rn - own[1]); o.y = cvtpk(s[2] * rn - own[2], s[3] * rn - own[3]);
        o.z = cvtpk(s[4] * rn - own[4], s[5] * rn - own[5]); o.w = cvtpk(s[6] * rn - own[6], s[7] * rn - own[7]);
        *(u32x4*)(Y + (size_t)(tok0 + ti) * D + c8) = o;
        const unsigned od[4] = {rows[ti].x, rows[ti].y, rows[ti].z, rows[ti].w};
#pragma unroll
        for (int e = 0; e < 4; ++e) { s[2 * e] -= __builtin_bit_cast(float, od[e] << 16); s[2 * e + 1] -= __builtin_bit_cast(float, od[e] & 0xffff0000u); }
    }
}
__device__ __forceinline__ void phase_pool(const Frame& F) {
    unsigned char* ws = F.ws;
    const bf16_t* U = (const bf16_t*)(ws + WS_R0);
    bf16_t* Y = (bf16_t*)(ws + WS_R0 + R0_C);
    const int gw = F.bx * NWAVES + F.wave, NGW = F.G * NWAVES;
    for (int it = gw; it < (M / 8) * 4; it += NGW) {
        const int run = it >> 2, g = it & 3, tok0 = run * 8, t0 = tok0 % T;
        if (F.lane < PGW / 8) { const int c8 = g * PGW + 8 * F.lane;
            if (g == 0) pool_item<2>(U, Y, tok0, t0, c8); else if (g == 1) pool_item<4>(U, Y, tok0, t0, c8); else if (g == 2) pool_item<8>(U, Y, tok0, t0, c8); else pool_item<16>(U, Y, tok0, t0, c8); }
    }
}

__device__ __forceinline__ void final_norm_row(const bf16_t* xrow, const float* prow, const float* gain, float* orow, int lane) {
    u32x2 xw[8];
#pragma unroll
    for (int j = 0; j < 8; ++j) xw[j] = ((const u32x2*)xrow)[lane + 64 * j];
    float p = prow[lane & 31];
#pragma unroll
    for (int o = 1; o < 32; o <<= 1) p += __shfl_xor(p, o);
    const float rstd = 1.0f / sqrtf(p * (1.0f / D) + EPS);
#pragma unroll
    for (int j = 0; j < 8; ++j) { const f32x4 gv = ((const f32x4*)gain)[lane + 64 * j];
        const f32x4 v = (f32x4){__builtin_bit_cast(float, xw[j].x << 16), __builtin_bit_cast(float, xw[j].x & 0xffff0000u), __builtin_bit_cast(float, xw[j].y << 16), __builtin_bit_cast(float, xw[j].y & 0xffff0000u)};
        ((f32x4*)orow)[lane + 64 * j] = v * rstd * gv; }
}
__device__ __forceinline__ void final_norm_row2(const bf16_t* x0, const bf16_t* x1, const float* p0, const float* p1, const float* gain, float* o0, float* o1, int lane) {
    u32x2 xa[8], xb[8];
#pragma unroll
    for (int j = 0; j < 8; ++j) { xa[j] = ((const u32x2*)x0)[lane + 64 * j]; xb[j] = ((const u32x2*)x1)[lane + 64 * j]; }
    float pa = p0[lane & 31], pb = p1[lane & 31];
#pragma unroll
    for (int o = 1; o < 32; o <<= 1) { pa += __shfl_xor(pa, o); pb += __shfl_xor(pb, o); }
    const float ra = 1.0f / sqrtf(pa * (1.0f / D) + EPS), rb = 1.0f / sqrtf(pb * (1.0f / D) + EPS);
#pragma unroll
    for (int j = 0; j < 8; ++j) { const f32x4 gv = ((const f32x4*)gain)[lane + 64 * j];
        const f32x4 va = (f32x4){__builtin_bit_cast(float, xa[j].x << 16), __builtin_bit_cast(float, xa[j].x & 0xffff0000u), __builtin_bit_cast(float, xa[j].y << 16), __builtin_bit_cast(float, xa[j].y & 0xffff0000u)};
        const f32x4 vb = (f32x4){__builtin_bit_cast(float, xb[j].x << 16), __builtin_bit_cast(float, xb[j].x & 0xffff0000u), __builtin_bit_cast(float, xb[j].y << 16), __builtin_bit_cast(float, xb[j].y & 0xffff0000u)};
        ((f32x4*)o0)[lane + 64 * j] = va * ra * gv; ((f32x4*)o1)[lane + 64 * j] = vb * rb * gv; }
}
__device__ __forceinline__ void phase_rstd(const Frame& F) {
    const float* part = (const float*)(F.ws + WS_PART); float* rstd = (float*)(F.ws + WS_RSTD);
    const int gw = F.bx * NWAVES + F.wave, NGW = F.G * NWAVES;
    for (int r2 = gw; r2 < M / 2; r2 += NGW) { const int row = 2 * r2 + (F.lane >> 5);
        float p = part[(size_t)row * 32 + (F.lane & 31)];
#pragma unroll
        for (int o = 1; o < 32; o <<= 1) p += __shfl_xor(p, o);
        if ((F.lane & 31) == 0) rstd[row] = 1.0f / sqrtf(p * (1.0f / D) + EPS); }
}

__device__ __forceinline__ bool panel_rstd(const Frame& F, const pg8::StaticOrder& S0, LAS float* ltab = nullptr) {
    pg8::StaticOrder S = S0; asm volatile("" : "+s"(S.c), "+s"(S.G), "+s"(S.nN));
    int tl = F.tid; asm volatile("" : "+v"(tl));
    const float* part = (const float*)(F.ws + WS_PART); float* rstd = (float*)(F.ws + WS_RSTD);
    int last = -1, np = 0; pg8::Unit u;
    for (int i = 0; S.next(i, u); ++i) if (u.pm != last) { last = u.pm; ++np;
        const int row = 256 * u.pm + (tl >> 1); const f32x4* pp = (const f32x4*)(part + (size_t)row * 32 + 16 * (tl & 1));
        const f32x4 a = pp[0], b = pp[1], c = pp[2], d = pp[3];
        float p = ((a.x + a.y) + (a.z + a.w)) + ((b.x + b.y) + (b.z + b.w)) + ((c.x + c.y) + (c.z + c.w)) + ((d.x + d.y) + (d.z + d.w));
        p += __shfl_xor(p, 1);
        const float rv = 1.0f / sqrtf(p * (1.0f / D) + EPS);
        if ((tl & 1) == 0) { rstd[row] = rv; if (ltab) ltab[tl >> 1] = rv; } }
    VM_WAIT(); LGKM_WAIT(); __syncthreads();
    return np == 1;
}

__device__ __forceinline__ void panel_rstdq(const Frame& F, const pg8::StaticOrder& S0) {
    pg8::StaticOrder S = S0; asm volatile("" : "+s"(S.c), "+s"(S.G), "+s"(S.nN));
    int tl = F.tid; asm volatile("" : "+v"(tl));
    const float* part = (const float*)(F.ws + WS_PARTQ); float* rstd = (float*)(F.ws + WS_RSTDQ);
    int last = -1; pg8::Unit u;
    for (int i = 0; S.next(i, u); ++i) if (u.pm != last) { last = u.pm;
        const int row = 256 * u.pm + (tl >> 1); const f32x4 a = *(const f32x4*)(part + (size_t)row * 8 + 4 * (tl & 1));
        float p = (a.x + a.y) + (a.z + a.w); p += __shfl_xor(p, 1);
        if ((tl & 1) == 0) rstd[row] = 1.0f / sqrtf(p * (1.0f / QL) + EPS); }
    VM_WAIT(); __syncthreads();
}

constexpr int PH_PER_LAYER = 10, N_PHASES = 1 + DEPTH * PH_PER_LAYER;

__global__ void __launch_bounds__(NWAVES * 64, 2) trunk_fwd(Args args) {
    extern __shared__ __attribute__((aligned(16))) unsigned char lds_raw[];
    LAS unsigned char* const lds = (LAS unsigned char*)lds_raw;
    volatile LAS unsigned* misc = (volatile LAS unsigned*)(lds + LDS_MISC_OFF);
    if (threadIdx.x < 16) misc[threadIdx.x] = 0u;
    const int wv0 = __builtin_amdgcn_readfirstlane((int)threadIdx.x >> 6);
    __syncthreads();
    unsigned* barw = (unsigned*)(args.ws + WS_CTL) + 4096 + (size_t)args.li * XCD_BAR_WORDS;
    XcdBarrier bar; bar.bar = barw; bar.x = 0; bar.st = misc; bar.wv = wv0;
    if ((args.ph_hi - args.ph_lo) > 1) bar = xcd_barrier_post(barw, misc, wv0);
    const int lo = args.ph_lo, hi = args.ph_hi;
#define IN(k) (lo <= (k) && (k) < hi)
#define SEAM(k) do { if (IN(k) && IN((k) + 1)) { XcdBarrier b2 = bar; asm volatile("" : "+s"(b2.bar), "+s"(b2.x)); xcd_barrier(b2); } } while (0)
#define SITE() const Frame F = make_frame(lds, wv0); unsigned char* const ws = F.ws; (void)ws

    _Pragma("unroll") for (int rep = 0; rep < NREP(0); ++rep) { if (IN(0)) { SITE(); phase_prologue(F); } }
    SEAM(0);

    for (int l = 0; l < DEPTH; ++l) {
        const int pb = 1 + l * PH_PER_LAYER, j = l >> 1;
        const bool dsa = (l & 1) == 0;
        if (dsa) {
            if (IN(pb + 0)) {
                _Pragma("unroll") for (int rep = 0; rep < NREP(1); ++rep) { SITE(); pg8::Gemm g{(const bf16_t*)(ws + WS_XRES), (const bf16_t*)(ws + WS_BT_INATTN) + (size_t)j * ATTN_IN_PAD * D, D, D, D, M / 256, ATTN_IN_PAD / 256, 1 << 20, 0};
                  pg8::StaticOrder S; S.init(g.nM, g.nN, F.G, F.bx); pg8::EpiInAttn E{(float*)(ws + WS_R0), ATTN_IN_PAD, (const float*)(ws + WS_RSTD), (bf16_t*)(ws + WS_CQN), (float*)(ws + WS_PARTQ), ws + WS_CQ8, (bf16_t*)(ws + WS_QMEM)};
                  if (l > 0) panel_rstd(F, S);
                  pg8::gemm_phase<pg8::EpiInAttn>(F.lds, F.tid, F.wave, g, S, E); }
                if (l == 0) _Pragma("unroll") for (int rep = 0; rep < NREP(2); ++rep) {
                    SITE(); pg8::Gemm g{(const bf16_t*)(ws + WS_MEMN), (const bf16_t*)(ws + WS_BT_MEMKV), D, D, D, 1024 / 256, 4096 / 256, 1 << 20, 0};
                    pg8::StaticOrder S; S.init(g.nM, g.nN, F.G, (F.bx + F.G / 2) % F.G); pg8::EpiSplit E{(bf16_t*)(ws + WS_MKV), 4096, (bf16_t*)(ws + WS_MKV), 4096, 1 << 20, 1.0f};
                    pg8::gemm_phase<pg8::EpiSplit>(F.lds, F.tid, F.wave, g, S, E); }
                if (l == 0) {
                    { SITE(); pg8::Gemm g{(const bf16_t*)(ws + WS_BT_OUTT), (const bf16_t*)(ws + WS_BT_GROUP), 2 * PW, PGW, PGW, D / 256, 2 * 2048 / 256, 2, PGW};
                        const int q = F.G / 4, cf = F.bx >= F.G - q ? F.bx - (F.G - q) : (1 << 20);
                        pg8::StaticOrder S; S.init(g.nM, g.nN, q, cf); pg8::EpiGroup E{(bf16_t*)(ws + WS_BT_OUT + SZ_BT_OUT), D, (int)(SZ_BT_OUT) - PW};
                        pg8::gemm_phase<pg8::EpiGroup>(F.lds, F.tid, F.wave, g, S, E); }
                    { SITE(); pg8::Gemm g{(const bf16_t*)(ws + WS_BT_OUTTD), (const bf16_t*)(ws + WS_BT_UV), 2 * PW, HD, HD, D / 256, 2 * NH, 1, HD};
                        const int q = F.G / 4, cf = F.bx >= F.G - q ? F.bx - (F.G - q) : (1 << 20);
                        pg8::StaticOrder S; S.init(g.nM, g.nN, q, cf); pg8::EpiFp8 E{ws + WS_BT_OUT, YW8, W8_SCALE, NH, (int)(2 * SZ_BT_OUT) - QABS_W_};
                        pg8::gemm_phase<pg8::EpiFp8>(F.lds, F.tid, F.wave, g, S, E); }
                }
            }
            SEAM(pb + 0);
            if (IN(pb + 2)) {
                _Pragma("unroll") for (int rep = 0; rep < NREP(3); ++rep) { SITE(); phase_postproj(F, F.in(12) + j * QL, F.in(13) + j * KVL, F.in(18) + j * IDM, F.in(19) + j * IDM); }
                _Pragma("unroll") for (int rep = 0; rep < NREP(4); ++rep) {
                    { SITE(); pg8::Gemm g{(const bf16_t*)(ws + WS_CQ8), (const bf16_t*)(ws + WS_BT_QA8 + (size_t)j * QABS_W_ * QL), QL / 2, QL / 2, QL / 2, M / 256, QABS_W / 256, 1 << 20, 0};
                      pg8::StaticOrder S; S.init(g.nM, g.nN, F.G, F.bx); pg8::EpiFp8RS E{ws + WS_R0, QABS_W, (const float*)(ws + WS_RSTDQ), QA8_SCALE / QW8_SCALE};
                      panel_rstdq(F, S);
                      pg8::gemm_phase<pg8::EpiFp8RS, true>(F.lds, F.tid, F.wave, g, S, E); }
                    { SITE(); pg8::Gemm g{(const bf16_t*)(ws + WS_CQN), (const bf16_t*)(ws + WS_BT_Q) + (size_t)j * NQ * QL + (size_t)QABS_W * QL, QL, QL, QL, M / 256, 1024 / 256, 1 << 20, 0};
                      pg8::StaticOrder S; S.init(g.nM, g.nN, F.G, F.bx); pg8::EpiSplitRS E{(bf16_t*)(ws + WS_R0 + R0_B), 1024, (bf16_t*)(ws + WS_R0 + R0_B), 1024, 1 << 20, (const float*)(ws + WS_RSTDQ), 1.0f};
                      panel_rstdq(F, S);
                      pg8::gemm_phase<pg8::EpiSplitRS>(F.lds, F.tid, F.wave, g, S, E); }
                } }
            SEAM(pb + 2);
            if (IN(pb + 3)) { _Pragma("unroll") for (int rep = 0; rep < NREP(5); ++rep) { SITE(); phase_dsa(F, rep + 1 < NREP(5)); } _Pragma("unroll") for (int rep = 0; rep < NREP(6); ++rep) { SITE(); phase_memattn<false>(F, l); } }
            SEAM(pb + 3);
        } else {
            if (IN(pb + 0)) _Pragma("unroll") for (int rep = 0; rep < NREP(8); ++rep) {
                SITE(); pg8::Gemm g{(const bf16_t*)(ws + WS_XRES), (const bf16_t*)(ws + WS_BT_INPOOL) + (size_t)j * D * D, D, D, D, M / 256, D / 256, 1 << 20, 0};
                pg8::StaticOrder S; S.init(g.nM, g.nN, F.G, F.bx); pg8::EpiSplitRS E{(bf16_t*)(ws + WS_R0), PW, (bf16_t*)(ws + WS_QMEM), MW, PW / 256, (const float*)(ws + WS_RSTD), 1.0f};
                panel_rstd(F, S);
                pg8::gemm_phase<pg8::EpiSplitRS>(F.lds, F.tid, F.wave, g, S, E);
            }
            SEAM(pb + 0);
            if (IN(pb + 3)) { _Pragma("unroll") for (int rep = 0; rep < NREP(9); ++rep) { SITE(); phase_pool(F); } _Pragma("unroll") for (int rep = 0; rep < NREP(6); ++rep) { SITE(); phase_memattn<true>(F, l); } }
            SEAM(pb + 3);
        }
        if (IN(pb + 5)) _Pragma("unroll") for (int rep = 0; rep < NREP(11); ++rep) {
            if (dsa) { SITE(); pg8::Gemm g{(const bf16_t*)(ws + WS_R0 + R0_C), (const bf16_t*)(ws + WS_BT_OUT + (size_t)l * SZ_BT_OUT), YW8 / 2, YW8 / 2, YW8 / 2, M / 256, D / 256, 1 << 20, 0};
                pg8::StaticOrder S; S.init(g.nM, g.nN, F.G, F.bx); pg8::EpiResid<true> E{(bf16_t*)(ws + WS_XRES), ws + WS_H, (float*)(ws + WS_PART), 1.0f / (W8_SCALE * Y8_SCALE)};
                pg8::gemm_phase<pg8::EpiResid<true>, true>(F.lds, F.tid, F.wave, g, S, E); }
            else { SITE(); pg8::Gemm g{(const bf16_t*)(ws + WS_R0 + R0_C), (const bf16_t*)(ws + WS_BT_OUT + (size_t)l * SZ_BT_OUT), D, D, D, M / 256, D / 256, 1 << 20, 0};
                pg8::StaticOrder S; S.init(g.nM, g.nN, F.G, F.bx); pg8::EpiResid<true> E{(bf16_t*)(ws + WS_XRES), ws + WS_H, (float*)(ws + WS_PART), 1.0f};
                pg8::gemm_phase<pg8::EpiResid<true>>(F.lds, F.tid, F.wave, g, S, E); }
        }
        SEAM(pb + 5);
        if (IN(pb + 7)) _Pragma("unroll") for (int rep = 0; rep < NREP(13); ++rep) {
            SITE(); pg8::Gemm g{(const bf16_t*)(ws + WS_H), (const bf16_t*)(ws + WS_BT_GU + (size_t)l * SZ_BT_GU), D / 2, D / 2, D / 2, M / 256, 2 * DFF / 256, 1 << 20, 0};
            pg8::StaticOrder S; S.init(g.nM, g.nN, F.G, F.bx); LAS float* ltab = (LAS float*)(F.lds + LDS_IDX_OFF);
            const bool one = panel_rstd(F, S, ltab);
            pg8::EpiSwiGLU E{ws + WS_R0, DFF, 1.0f / W8_SCALE, (const float*)(ws + WS_RSTD), one ? ltab : nullptr};
            pg8::gemm_phase<pg8::EpiSwiGLU, true>(F.lds, F.tid, F.wave, g, S, E);
        }
        SEAM(pb + 7);
        if (IN(pb + 8)) _Pragma("unroll") for (int rep = 0; rep < NREP(14); ++rep) {
            SITE(); pg8::Gemm g{(const bf16_t*)(ws + WS_R0), (const bf16_t*)(ws + WS_BT_DOWN + (size_t)l * D * DFF), DFF / 2, DFF / 2, DFF / 2, M / 256, D / 256, 1 << 20, 0};
            pg8::StaticOrder S; S.init(g.nM, g.nN, F.G, F.bx);
            pg8::EpiResid<false> E{(bf16_t*)(ws + WS_XRES), nullptr, (float*)(ws + WS_PART), 1.0f / (W8_SCALE * GU8_SCALE)}; pg8::gemm_phase<pg8::EpiResid<false>, true>(F.lds, F.tid, F.wave, g, S, E);
        }
        SEAM(pb + 8);
        if (IN(pb + 9) && l + 1 == DEPTH) { SITE();
            const int gw = F.bx * NWAVES + F.wave, NGW = F.G * NWAVES; const bf16_t* xres = (const bf16_t*)(ws + WS_XRES); const float* part = (const float*)(ws + WS_PART); const float* gn = F.in(4); float* outp = F.out();
            int m = gw;
            for (; m + NGW < M; m += 2 * NGW) final_norm_row2(xres + (size_t)m * D, xres + (size_t)(m + NGW) * D, part + (size_t)m * 32, part + (size_t)(m + NGW) * 32, gn, outp + (size_t)m * D, outp + (size_t)(m + NGW) * D, F.lane);
            for (; m < M; m += NGW) final_norm_row(xres + (size_t)m * D, part + (size_t)m * 32, gn, outp + (size_t)m * D, F.lane); }
    }
#undef IN
#undef SEAM
#undef SITE
}

extern "C" void kernel_launch(void* const* d_in, const int* in_sizes, int n_in, void* d_out, int out_size, void* d_ws, size_t ws_size, hipStream_t stream) {
    static int grid = 0;
    if (grid == 0) {
        if (n_in != 23 || in_sizes[0] != M * D || out_size != M * D || ws_size < WS_END) {
            fprintf(stderr, "kernel_launch: unexpected shapes (n_in %d, in0 %d, out %d, ws %zu, need %zu); nothing launched\n", n_in, n_in > 0 ? in_sizes[0] : -1, out_size, ws_size, (size_t)WS_END); grid = -1; return; }
        int dev = 0, cus = 0, per_cu = 0;
        if (hipGetDevice(&dev) != hipSuccess || hipDeviceGetAttribute(&cus, hipDeviceAttributeMultiprocessorCount, dev) != hipSuccess) { grid = -1; return; }
        if (hipFuncSetAttribute((const void*)trunk_fwd, hipFuncAttributeMaxDynamicSharedMemorySize, LDS_BYTES) != hipSuccess) { fprintf(stderr, "kernel_launch: hipFuncSetAttribute failed\n"); grid = -1; return; }
        if (hipOccupancyMaxActiveBlocksPerMultiprocessor(&per_cu, (const void*)trunk_fwd, NWAVES * 64, LDS_BYTES) != hipSuccess || per_cu < 1) {
            fprintf(stderr, "kernel_launch: occupancy query reports %d workgroups per CU\n", per_cu); (void)hipGetLastError(); grid = -1; return; }
        grid = cus;
    }
    if (grid < 0) return;
    if (hipMemsetAsync((char*)d_ws + WS_CTL, 0, CTL_BYTES, stream) != hipSuccess) return;
    Args a{};
    for (int i = 0; i < 23; ++i) a.in[i] = (const float*)d_in[i];
    a.out = (float*)d_out; a.ws = (unsigned char*)d_ws;
#if MK_N_LAUNCHES == 1
    a.ph_lo = 0; a.ph_hi = N_PHASES; a.li = 0;
    hipLaunchKernelGGL(trunk_fwd, dim3(grid), dim3(NWAVES * 64), LDS_BYTES, stream, a);
#else
    for (int p = 0; p < N_PHASES; ++p) {
        if (p >= 1) { const int l = (p - 1) / PH_PER_LAYER, k = (p - 1) % PH_PER_LAYER; if (k == 4 || ((l & 1) == 1 && (k == 1 || k == 2))) continue; }
        a.ph_lo = p; a.ph_hi = p + 1; a.li = 0;
        hipLaunchKernelGGL(trunk_fwd, dim3(grid), dim3(NWAVES * 64), LDS_BYTES, stream, a);
    }
#endif
}
```
